# Optimizing an MI355X kernel written in HIP

```python
import jax, jax.numpy as jnp
from jax import lax
import numpy as np

D_MODEL = 2048
BATCH = 4
SEQ = 8192
DEPTH = 1

D_MIX = D_MODEL
D_HGRN = D_MIX // 2
HGRN_HEAD = 128
HGRN_HEADS = D_HGRN // HGRN_HEAD
HGRN_CHUNK = 64
D_ATTN = D_MIX - D_HGRN
ATTN_HEAD = 64
ATTN_HEADS = D_ATTN // ATTN_HEAD
DILATED_PATTERNS = ((128, 1), (512, 4), (2048, 16))
NORM_EPS = 1e-6
SPLIT_WIDTHS = (D_HGRN, D_HGRN, D_HGRN, D_HGRN, D_ATTN, D_ATTN, D_ATTN, D_ATTN)
D_IN = sum(SPLIT_WIDTHS)

kernel_name = "hymba_hgrn2_dilated_alibi_block"


def rms_norm(x, gain):
    xf = x.astype(jnp.float32)
    y = xf * lax.rsqrt(jnp.mean(xf * xf, axis=-1, keepdims=True) + NORM_EPS)
    return (y * gain.astype(jnp.float32)).astype(x.dtype)


def alibi_slopes(n_heads):
    return jnp.exp2(-8.0 * jnp.arange(1, n_heads + 1, dtype=jnp.float32) / n_heads)


def chunked_gated_recurrence(q, k, log_f, v):
    B, H, S, Dk = q.shape
    Dv = v.shape[-1]
    C = HGRN_CHUNK
    N = S // C
    q, k, log_f = (a.reshape(B, H, N, C, Dk) for a in (q, k, log_f))
    v = v.reshape(B, H, N, C, Dv)
    b = jnp.cumsum(log_f, axis=3)
    b_last = b[:, :, :, -1:, :]
    q_dec = q * jnp.exp(b)
    k_dec = k * jnp.exp(-b)
    k_end = k * jnp.exp(b_last - b)
    causal = jnp.tril(jnp.ones((C, C), dtype=bool))
    a_intra = jnp.where(causal, jnp.einsum('bhncd,bhnsd->bhncs', q_dec, k_dec), 0.0)
    o_intra = jnp.einsum('bhncs,bhnsv->bhncv', a_intra, v)
    kv_chunk = jnp.einsum('bhncd,bhncv->nbhdv', k_end, v)
    chunk_decay = jnp.exp(b_last[:, :, :, 0, :]).transpose(2, 0, 1, 3)

    def step(state, inp):
        dec, kv_n = inp
        return dec[..., None] * state + kv_n, state

    _, prev_states = lax.scan(step, jnp.zeros((B, H, Dk, Dv), jnp.float32),
                              (chunk_decay, kv_chunk))
    o_inter = jnp.einsum('bhncd,nbhdv->bhncv', q_dec, prev_states)
    return (o_intra + o_inter).reshape(B, H, S, Dv)


def hgrn2_mixer(q_pre, f_pre, i_pre, lb, g_norm):
    B, S, _ = q_pre.shape

    def heads(a):
        return a.astype(jnp.float32).reshape(B, S, HGRN_HEADS, HGRN_HEAD).transpose(0, 2, 1, 3)

    q = jax.nn.silu(heads(q_pre))
    lbh = lb.astype(jnp.float32).reshape(HGRN_HEADS, 1, HGRN_HEAD)
    f = lbh + (1.0 - lbh) * jax.nn.sigmoid(heads(f_pre))
    k = 1.0 - f
    o = chunked_gated_recurrence(q, k, jnp.log(f), heads(i_pre))
    o = o * lax.rsqrt(jnp.mean(o * o, axis=-1, keepdims=True) + NORM_EPS) * g_norm.astype(jnp.float32)
    return o.transpose(0, 2, 1, 3).reshape(B, S, D_HGRN)


def dilated_pattern_attention(q, k, v, slopes, window, dilation):
    B, H, S, Dh = q.shape
    d = dilation
    W = window // d
    L = S // d
    nb = -(-L // W)
    Lp = nb * W

    def regroup(a):
        a = a.reshape(B, H, L, d, Dh).transpose(0, 1, 3, 2, 4)
        a = jnp.pad(a, ((0, 0), (0, 0), (0, 0), (0, Lp - L), (0, 0)))
        return a.reshape(B, H, d, nb, W, Dh)

    def with_prev_block(a):
        prev = jnp.pad(a, ((0, 0), (0, 0), (0, 0), (1, 0), (0, 0), (0, 0)))[:, :, :, :-1]
        return jnp.concatenate([prev, a], axis=4)

    qb = regroup(q)
    kc = with_prev_block(regroup(k))
    vc = with_prev_block(regroup(v))
    s = jnp.einsum('bhrnqd,bhrnkd->bhrnqk', qb, kc) * (Dh ** -0.5)
    i_idx = jnp.arange(W)[:, None]
    j_idx = jnp.arange(2 * W)[None, :]
    delta = W + i_idx - j_idx
    blk = jnp.arange(nb)[:, None, None]
    valid = (delta >= 0) & (delta <= W) & ((blk - 1) * W + j_idx >= 0)
    bias = -slopes[:, None, None] * (d * delta).astype(jnp.float32)
    s = jnp.where(valid, s + bias[None, :, None, None], -jnp.inf)
    m = jnp.max(s, axis=-1, keepdims=True)
    p = jnp.exp(s - m)
    den = jnp.sum(p, axis=-1, keepdims=True)
    o = jnp.einsum('bhrnqk,bhrnkd->bhrnqd', p, vc) / den
    lse = (m + jnp.log(den))[..., 0]
    o = o.reshape(B, H, d, Lp, Dh)[:, :, :, :L].transpose(0, 1, 3, 2, 4).reshape(B, H, S, Dh)
    lse = lse.reshape(B, H, d, Lp)[:, :, :, :L].transpose(0, 1, 3, 2).reshape(B, H, S)
    return o, lse


def dilated_attention_mixer(q_pre, k_pre, v_pre):
    B, S, _ = q_pre.shape

    def heads(a):
        return a.astype(jnp.float32).reshape(B, S, ATTN_HEADS, ATTN_HEAD).transpose(0, 2, 1, 3)

    q, k, v = heads(q_pre), heads(k_pre), heads(v_pre)
    slopes = alibi_slopes(ATTN_HEADS)
    outs, lses = [], []
    for window, dilation in DILATED_PATTERNS:
        o, lse = dilated_pattern_attention(q, k, v, slopes, window, dilation)
        outs.append(o)
        lses.append(lse)
    weights = jax.nn.softmax(jnp.stack(lses, axis=0), axis=0)
    o = jnp.einsum('pbhs,pbhsd->bhsd', weights, jnp.stack(outs, axis=0))
    return o.transpose(0, 2, 1, 3).reshape(B, S, D_ATTN)


def setup_inputs(seed: int = 0) -> dict:
    key = jax.random.key(seed)
    ks = jax.random.split(key, 8)
    x = jax.random.normal(ks[0], (BATCH, SEQ, D_MODEL), jnp.float32)
    norm_gain = 1.0 + 0.01 * jax.random.normal(ks[1], (DEPTH, D_MODEL), jnp.float32)
    w_in = jax.random.normal(ks[2], (DEPTH, D_MODEL, D_IN), jnp.float32) * D_MODEL ** -0.5
    lb_logits = 0.1 * jax.random.normal(ks[3], (DEPTH + 1, D_HGRN), jnp.float32)
    hgrn_gnorm = 1.0 + 0.01 * jax.random.normal(ks[4], (DEPTH, HGRN_HEAD), jnp.float32)
    w_out = jax.random.normal(ks[5], (DEPTH, D_MIX, D_MODEL), jnp.float32) * D_MIX ** -0.5
    final_gain = 1.0 + 0.01 * jax.random.normal(ks[6], (D_MODEL,), jnp.float32)
    return {"x": x, "norm_gain": norm_gain, "w_in": w_in, "lb_logits": lb_logits,
            "hgrn_gnorm": hgrn_gnorm, "w_out": w_out, "final_gain": final_gain}


def reference(x, norm_gain, w_in, lb_logits, hgrn_gnorm, w_out, final_gain):
    lb_all = jnp.cumsum(jax.nn.softmax(lb_logits.astype(jnp.float32), axis=0), axis=0)
    split_points = [int(v) for v in np.cumsum(SPLIT_WIDTHS)[:-1]]
    for layer in range(DEPTH):
        h = rms_norm(x, norm_gain[layer])
        z = jnp.einsum('bsd,de->bse', h, w_in[layer])
        q_h, f_h, i_h, g_h, q_a, k_a, v_a, g_a = jnp.split(z, split_points, axis=-1)
        y_h = hgrn2_mixer(q_h, f_h, i_h, lb_all[layer], hgrn_gnorm[layer]) * jax.nn.silu(g_h.astype(jnp.float32))
        y_a = dilated_attention_mixer(q_a, k_a, v_a) * jax.nn.silu(g_a.astype(jnp.float32))
        y = jnp.concatenate([y_h, y_a], axis=-1).astype(x.dtype)
        x = x + jnp.einsum('bse,ed->bsd', y, w_out[layer])
    return rms_norm(x, final_gain)
```

```cpp
#include <hip/hip_runtime.h>
#include <cstdio>
#include <cstdint>
namespace pg8 {
#define PG8_LAS __attribute__((address_space(3)))
typedef unsigned short bf16_t;
typedef short bf16x8 __attribute__((ext_vector_type(8)));
typedef float f32x4 __attribute__((ext_vector_type(4)));
typedef unsigned u32x4 __attribute__((ext_vector_type(4)));
constexpr int BM = 256, BK = 64, HALF = 128, HTB = HALF * BK * 2  , STAGE_BYTES = 8 * HTB, NXCD = 8, WGM = 8;

__host__ __device__ __forceinline__ int lds_byte(int r, int c) { const int st = (r >> 4) * 2 + (c >> 5), rr = r & 15, cc = c & 31, ob = rr * 64 + cc * 2; return st * 1024 + (ob ^ (((ob >> 9) & 1) << 5)); }
__host__ __device__ __forceinline__ void stage_rc(int b, int& R, int& C) { const int st = b / 1024, sb = b % 1024, swz = sb ^ (((sb >> 9) & 1) << 5); R = (st >> 1) * 16 + swz / 64; C = (st & 1) * 32 + (swz % 64) / 2; }
__host__ __device__ __forceinline__ int perm32(int rho) { const int n = rho >> 4, i = rho & 15; return 8 * (i >> 2) + 4 * n + (i & 3); }

struct Unit { int pm, pn; };
struct Gemm { const bf16_t* A; const bf16_t* Bt; int M, N, K; };

struct StaticOrder {
    int nM, nN, nwg, G, c;
    __host__ __device__ void init(int M, int N, int G_, int c_) { nM = M / BM; nN = N / BM; nwg = nM * nN; G = G_; c = c_; }
    __host__ __device__ bool next(int i, Unit& u) const {
        const long L = (long)i * G + c; if (L >= nwg) return false;
        int wgid = (int)L; { const int q = nwg / NXCD, r = nwg % NXCD, xcd = wgid % NXCD, off = wgid / NXCD; wgid = (xcd < r ? xcd * (q + 1) : r * (q + 1) + (xcd - r) * q) + off; }
        const int nig = WGM * nN, gid = wgid / nig, fm = gid * WGM, gsz = (nM - fm) < WGM ? (nM - fm) : WGM;
        u.pm = fm + ((wgid % nig) % gsz); u.pn = (wgid % nig) / gsz; return true;
    }
    __device__ __forceinline__ void a_ready(const Unit&) const {}
    __device__ __forceinline__ void done(const Unit&) const {}
};

__device__ __forceinline__ unsigned cvt_pk_bf16(float lo, float hi) { unsigned r; asm volatile("v_cvt_pk_bf16_f32 %0, %1, %2" : "=v"(r) : "v"(lo), "v"(hi)); return r; }
typedef float f32x2 __attribute__((ext_vector_type(2)));
struct EpiBf16 {
    static constexpr bool PERM = true, AFTER_DRAIN = false;
    bf16_t* O; int ldc;
    __device__ __forceinline__ void operator()(const f32x4 (&acc)[2][2][4][2], const Unit& u, int wr, int wc, int fr, int fq) const {
        const int row0 = u.pm * BM + wr * 64 + fr; const int col0 = u.pn * BM + wc * 32 + 8 * fq;
#pragma unroll
        for (int ai = 0; ai < 2; ++ai)
#pragma unroll
            for (int m = 0; m < 4; ++m) { bf16_t* rowp = O + (size_t)(row0 + ai * HALF + m * 16) * ldc + col0;
#pragma unroll
                for (int bj = 0; bj < 2; ++bj) { const f32x4 v0 = acc[ai][bj][m][0], v1 = acc[ai][bj][m][1];
                    u32x4 w; w.x = cvt_pk_bf16(v0[0], v0[1]); w.y = cvt_pk_bf16(v0[2], v0[3]); w.z = cvt_pk_bf16(v1[0], v1[1]); w.w = cvt_pk_bf16(v1[2], v1[3]);
                    *(u32x4*)(rowp + bj * HALF) = w; } }
    }
};
struct EpiResF32 {
    static constexpr bool PERM = false, AFTER_DRAIN = false;
    const float* base; float* C; int ldc;
    __device__ __forceinline__ void operator()(const f32x4 (&acc)[2][2][4][2], const Unit& u, int wr, int wc, int fr, int fq) const {
        const int row0 = u.pm * BM + wr * 64 + fr, col0 = u.pn * BM + wc * 32 + 4 * fq;
#pragma unroll
        for (int ai = 0; ai < 2; ++ai)
#pragma unroll
            for (int m = 0; m < 4; ++m) { const size_t off = (size_t)(row0 + ai * HALF + m * 16) * ldc + col0;
#pragma unroll
                for (int bj = 0; bj < 2; ++bj)
#pragma unroll
                    for (int n = 0; n < 2; ++n) *(f32x4*)(C + off + bj * HALF + n * 16) = *(const f32x4*)(base + off + bj * HALF + n * 16) + acc[ai][bj][m][n]; }
    }
};
template <class Epi, class Sched, bool ALIGN_EPI = false, bool SP2 = false>
__device__ __forceinline__ void gemm_phase(PG8_LAS unsigned char* lds, const Gemm g, const Sched& S, const Epi& E) {
    const int tid = threadIdx.x, wid = __builtin_amdgcn_readfirstlane(tid >> 6), lane = tid & 63, wr = wid >> 2, wc = wid & 3, fr = lane & 15, fq = lane >> 4;
    const int K = g.K, nt = K / BK;
    unsigned voffA[2], voffB[2];
#pragma unroll
    for (int i = 0; i < 2; ++i) { int R, C; stage_rc(tid * 16 + i * 8192, R, C); const int Rb = Epi::PERM ? ((R & ~31) + perm32(R & 31)) : R;
        voffA[i] = (unsigned)(R * K + C) * 2u; voffB[i] = (unsigned)(Rb * K + C) * 2u; }
    const size_t kstep = (size_t)(BK * 2);
    const size_t hstep = (size_t)HALF * K * 2;
    const size_t tstep = 2 * hstep;
    const unsigned ldsw = (unsigned)wid * 1024u;
    const int aoff = lds_byte(wr * 64 + fr, fq * 8), boff = lds_byte(wc * 32 + fr, fq * 8);
#define PG8_SA(b, h) (((b) * 2 + (h)) * HTB)
#define PG8_SB(b, h) ((4 + (b) * 2 + (h)) * HTB)
#define PG8_STAGE(bufoff, gbase, voff) do { _Pragma("unroll") for (int _i = 0; _i < 2; ++_i) \
        __builtin_amdgcn_global_load_lds((const unsigned*)((const char*)(gbase) + (voff)[_i]), (PG8_LAS unsigned*)(lds + (bufoff) + ldsw + _i * 8192), 16, 0, 0); } while (0)
#define PG8_LDA(dst, b, h) do { _Pragma("unroll") for (int m = 0; m < 4; ++m) _Pragma("unroll") for (int k = 0; k < 2; ++k) dst[m][k] = *(const PG8_LAS bf16x8*)(lds + PG8_SA(b, h) + aoff + m * 2048 + k * 1024); } while (0)
#define PG8_LDB(dst, b, h) do { _Pragma("unroll") for (int n = 0; n < 2; ++n) _Pragma("unroll") for (int k = 0; k < 2; ++k) dst[n][k] = *(const PG8_LAS bf16x8*)(lds + PG8_SB(b, h) + boff + n * 2048 + k * 1024); } while (0)
#define PG8_MMA(ai, bj, At, Bt) do { __builtin_amdgcn_s_setprio(1); _Pragma("unroll") for (int m = 0; m < 4; ++m) _Pragma("unroll") for (int n = 0; n < 2; ++n) _Pragma("unroll") for (int k = 0; k < 2; ++k) \
        acc[ai][bj][m][n] = __builtin_amdgcn_mfma_f32_16x16x32_bf16(Bt[n][k], At[m][k], acc[ai][bj][m][n], 0, 0, 0); __builtin_amdgcn_s_setprio(0); } while (0)
#define PG8_WAIT_V(n) asm volatile("s_waitcnt vmcnt(" #n ")" ::: "memory")
#define PG8_WAIT_L(n) asm volatile("s_waitcnt lgkmcnt(" #n ")" ::: "memory")
#define PG8_BAR __builtin_amdgcn_s_barrier()
#define PG8_SCHED __builtin_amdgcn_sched_barrier(0)
    Unit cur, nxt; int ui = 0;
    if (!S.next(0, cur)) return;
    f32x4 acc[2][2][4][2];
#pragma unroll
    for (int a = 0; a < 2; ++a)
#pragma unroll
        for (int b = 0; b < 2; ++b)
#pragma unroll
            for (int m = 0; m < 4; ++m)
#pragma unroll
                for (int n = 0; n < 2; ++n) acc[a][b][m][n] = (f32x4){0.f, 0.f, 0.f, 0.f};
    bf16x8 At[4][2], B0[2][2], B1[2][2];
    const char* cA = (const char*)g.A + (size_t)cur.pm * tstep; const char* cB = (const char*)g.Bt + (size_t)cur.pn * tstep;
    S.a_ready(cur);
    if constexpr (SP2) {
        PG8_STAGE(PG8_SB(0, 0), cB, voffB); PG8_STAGE(PG8_SB(0, 1), cB + hstep, voffB); PG8_STAGE(PG8_SA(0, 0), cA, voffA); PG8_STAGE(PG8_SA(0, 1), cA + hstep, voffA);
        if (wr == 1) PG8_BAR;
        PG8_WAIT_V(2); PG8_BAR;
        PG8_STAGE(PG8_SB(1, 0), cB + kstep, voffB); PG8_STAGE(PG8_SA(1, 0), cA + kstep, voffA); PG8_STAGE(PG8_SB(1, 1), cB + hstep + kstep, voffB);
        PG8_WAIT_V(6); PG8_BAR;
    } else {
        PG8_STAGE(PG8_SB(0, 0), cB, voffB); PG8_STAGE(PG8_SA(0, 0), cA, voffA); PG8_STAGE(PG8_SB(0, 1), cB + hstep, voffB); PG8_STAGE(PG8_SA(0, 1), cA + hstep, voffA);
        if (wr == 1) PG8_BAR;
        PG8_WAIT_V(4); PG8_BAR;
        PG8_STAGE(PG8_SB(1, 0), cB + kstep, voffB); PG8_STAGE(PG8_SA(1, 0), cA + kstep, voffA); PG8_STAGE(PG8_SB(1, 1), cB + hstep + kstep, voffB);
        PG8_WAIT_V(6); PG8_BAR;
    }
    for (;;) {
        const bool has_next = S.next(ui + 1, nxt);
        const char* nA = has_next ? (const char*)g.A + (size_t)nxt.pm * tstep : cA; const char* nB = has_next ? (const char*)g.Bt + (size_t)nxt.pn * tstep : cB;
        for (int t = 0; t < nt; t += 2) {
            const bool last = (t == nt - 2);
            const char* a1 = cA + (size_t)(t + 1) * kstep;
            const char* a2 = last ? nA : cA + (size_t)(t + 2) * kstep; const char* b2 = last ? nB : cB + (size_t)(t + 2) * kstep;
            const char* a3 = a2 + kstep; const char* b3 = b2 + kstep;
            if (last && has_next) S.a_ready(nxt);
            if constexpr (SP2) {
            PG8_LDB(B0, 0, 0); PG8_LDB(B1, 0, 1); PG8_SCHED; PG8_LDA(At, 0, 0); PG8_STAGE(PG8_SA(1, 1), a1 + hstep, voffA);
            PG8_WAIT_V(8); PG8_WAIT_L(0); PG8_BAR; PG8_MMA(0, 0, At, B0); PG8_MMA(0, 1, At, B1); PG8_BAR; PG8_SCHED;
            PG8_LDA(At, 0, 1); PG8_STAGE(PG8_SB(0, 0), b2, voffB); PG8_STAGE(PG8_SB(0, 1), b2 + hstep, voffB); PG8_STAGE(PG8_SA(0, 0), a2, voffA);
            PG8_WAIT_V(8); PG8_WAIT_L(0); PG8_BAR; PG8_MMA(1, 0, At, B0); PG8_MMA(1, 1, At, B1); PG8_BAR; PG8_SCHED;
            PG8_LDB(B0, 1, 0); PG8_LDB(B1, 1, 1); PG8_SCHED; PG8_LDA(At, 1, 0); PG8_STAGE(PG8_SA(0, 1), a2 + hstep, voffA);
            PG8_WAIT_V(8); PG8_WAIT_L(0); PG8_BAR; PG8_MMA(0, 0, At, B0); PG8_MMA(0, 1, At, B1); PG8_BAR; PG8_SCHED;
            PG8_LDA(At, 1, 1); PG8_STAGE(PG8_SB(1, 0), b3, voffB); PG8_STAGE(PG8_SB(1, 1), b3 + hstep, voffB); PG8_STAGE(PG8_SA(1, 0), a3, voffA);
            PG8_WAIT_V(8); PG8_WAIT_L(0); PG8_BAR; PG8_MMA(1, 0, At, B0); PG8_MMA(1, 1, At, B1); PG8_BAR; PG8_SCHED;
            } else {
            PG8_LDB(B0, 0, 0); PG8_SCHED; PG8_LDA(At, 0, 0); PG8_STAGE(PG8_SA(1, 1), a1 + hstep, voffA);
            PG8_WAIT_L(8); PG8_BAR; PG8_WAIT_L(0); PG8_MMA(0, 0, At, B0); PG8_BAR; PG8_SCHED;
            PG8_LDB(B1, 0, 1); PG8_STAGE(PG8_SB(0, 0), b2, voffB);
            PG8_BAR; PG8_WAIT_L(0); PG8_MMA(0, 1, At, B1); PG8_BAR;
            PG8_LDA(At, 0, 1); PG8_STAGE(PG8_SA(0, 0), a2, voffA);
            PG8_BAR; PG8_WAIT_L(0); PG8_MMA(1, 0, At, B0); PG8_BAR; PG8_SCHED;
            PG8_STAGE(PG8_SB(0, 1), b2 + hstep, voffB);
            PG8_WAIT_V(6); PG8_BAR; PG8_MMA(1, 1, At, B1); PG8_BAR;
            PG8_LDB(B0, 1, 0); PG8_SCHED; PG8_LDA(At, 1, 0); PG8_STAGE(PG8_SA(0, 1), a2 + hstep, voffA);
            PG8_WAIT_L(8); PG8_BAR; PG8_WAIT_L(0); PG8_MMA(0, 0, At, B0); PG8_BAR; PG8_SCHED;
            PG8_LDB(B1, 1, 1); PG8_STAGE(PG8_SB(1, 0), b3, voffB);
            PG8_BAR; PG8_WAIT_L(0); PG8_MMA(0, 1, At, B1); PG8_BAR;
            PG8_LDA(At, 1, 1); PG8_STAGE(PG8_SA(1, 0), a3, voffA);
            PG8_BAR; PG8_WAIT_L(0); PG8_MMA(1, 0, At, B0); PG8_BAR; PG8_SCHED;
            PG8_STAGE(PG8_SB(1, 1), b3 + hstep, voffB);
            PG8_WAIT_V(6); PG8_BAR; PG8_MMA(1, 1, At, B1); PG8_BAR;
            }
        }
        if constexpr (ALIGN_EPI) { if (wr == 0) PG8_BAR; }
        if constexpr (!Epi::AFTER_DRAIN) { E(acc, cur, wr, wc, fr, fq); S.done(cur); }
        if (!has_next) break;
#pragma unroll
        for (int a = 0; a < 2; ++a)
#pragma unroll
            for (int b = 0; b < 2; ++b)
#pragma unroll
                for (int m = 0; m < 4; ++m)
#pragma unroll
                    for (int n = 0; n < 2; ++n) acc[a][b][m][n] = (f32x4){0.f, 0.f, 0.f, 0.f};
        cur = nxt; cA = nA; cB = nB; ++ui;
        if constexpr (ALIGN_EPI) { if (wr == 1) PG8_BAR; }
    }
    PG8_WAIT_V(0);
    if constexpr (!ALIGN_EPI) { if (wr == 0) PG8_BAR; }
    PG8_BAR;
    if constexpr (Epi::AFTER_DRAIN) { E.fused(acc, cur, wr, wc, fr, fq, lds, wid, lane); S.done(cur); }
#undef PG8_SA
#undef PG8_SB
#undef PG8_STAGE
#undef PG8_LDA
#undef PG8_LDB
#undef PG8_MMA
#undef PG8_WAIT_V
#undef PG8_WAIT_L
#undef PG8_BAR
#undef PG8_SCHED
}
}
#define GAS __attribute__((address_space(1)))
#define LAS __attribute__((address_space(3)))
typedef unsigned short bf16;
typedef unsigned v4u __attribute__((ext_vector_type(4)));
typedef float f32x4 __attribute__((ext_vector_type(4)));
typedef short bf16x8 __attribute__((ext_vector_type(8)));
typedef GAS unsigned gu32;
typedef GAS unsigned long long gu64;
#define RLX_AGENT __ATOMIC_RELAXED, __HIP_MEMORY_SCOPE_AGENT
#define LDS_WAIT() asm volatile("s_waitcnt lgkmcnt(0)" ::: "memory")
#define VM_WAIT() asm volatile("s_waitcnt vmcnt(0)" ::: "memory")
__device__ __forceinline__ unsigned long long rt() { return __builtin_amdgcn_s_memrealtime(); }
__device__ __forceinline__ unsigned f2bf(float f) { unsigned u = __builtin_bit_cast(unsigned, f); return (u + 0x7fffu + ((u >> 16) & 1u)) >> 16; }
__device__ __forceinline__ unsigned pk2(float lo, float hi) { return f2bf(lo) | (f2bf(hi) << 16); }
#define XB_TMO      128
#define XB_XCNT(j)  (256  + 64 * (j))
#define XB_XSUB(j)  (1280 + 64 * (j))
#define XB_XGEN(j)  (2304 + 64 * (j))
#define XB_TOP      3328
#define XB_TOPGEN   3392
#define XCD_BAR_WORDS 3456
#define XB_SPIN_CAP (1u << 18)

__device__ __forceinline__ unsigned xb_ld(unsigned* p)              { return __hip_atomic_load(p, __ATOMIC_RELAXED, __HIP_MEMORY_SCOPE_AGENT); }
__device__ __forceinline__ unsigned xb_add(unsigned* p, unsigned v) { return __hip_atomic_fetch_add(p, v, __ATOMIC_RELAXED, __HIP_MEMORY_SCOPE_AGENT); }
__device__ __forceinline__ unsigned xb_xcc_id() { return (unsigned)__builtin_amdgcn_s_getreg((3 << 11) | 20) & 0xFu; }
#define XB_SPIN(cond, bar) do { unsigned _sp = 0; while (cond) { __builtin_amdgcn_s_sleep(1); \
    if ((++_sp & 255u) == 0u) { if (xb_ld(&(bar)[XB_TMO])) break; if (_sp > XB_SPIN_CAP) { atomicAdd(&(bar)[XB_TMO], 1u); break; } } } } while (0)

struct XcdBarrier {
    unsigned* bar; unsigned x;
    volatile LAS unsigned* st;
};

__device__ __forceinline__ XcdBarrier xcd_barrier_post(unsigned* bar, volatile LAS unsigned* st) {
    XcdBarrier b; b.bar = bar; b.x = xb_xcc_id(); b.st = st;
    if (threadIdx.x == 0) (void)xb_add(&bar[XB_XCNT(b.x)], 1u);
    return b;
}
__device__ __forceinline__ void xcd_barrier_complete(unsigned* bar, unsigned x, unsigned& nloc, unsigned& nx) {
    const unsigned G = gridDim.x * gridDim.y * gridDim.z;
    unsigned sum, cnt, mine, sp = 0u;
    for (;;) {
        sum = 0u; cnt = 0u; mine = 0u;
#pragma unroll
        for (unsigned j = 0; j < 16; ++j) { const unsigned c = xb_ld(&bar[XB_XCNT(j)]); sum += c; cnt += (c > 0u) ? 1u : 0u; mine = (j == x) ? c : mine; }
        if (sum == G) break;
        __builtin_amdgcn_s_sleep(1);
        if ((++sp & 255u) == 0u) { if (xb_ld(&bar[XB_TMO])) break; if (sp > XB_SPIN_CAP) { atomicAdd(&bar[XB_TMO], 1u); break; } }
    }
    nloc = mine > 0u ? mine : 1u; nx = cnt > 0u ? cnt : 1u;
}

__device__ __forceinline__ void xcd_barrier(const XcdBarrier& b) {
    asm volatile("s_waitcnt vmcnt(0)" ::: "memory");
    __syncthreads();
    if (threadIdx.x == 0) {
        unsigned* bar = b.bar;
        __builtin_amdgcn_s_waitcnt(0);
        unsigned nloc = b.st[0], nx = b.st[1];
        if (nloc == 0u) { xcd_barrier_complete(bar, b.x, nloc, nx); b.st[0] = nloc; b.st[1] = nx; }
        const unsigned old = xb_add(&bar[XB_XSUB(b.x)], 1u);
        const unsigned gen = old / nloc;
        if (old + 1u == (gen + 1u) * nloc) {
            __builtin_amdgcn_fence(__ATOMIC_RELEASE, "agent");
            asm volatile("s_waitcnt vmcnt(0)" ::: "memory");
            const unsigned og = xb_add(&bar[XB_TOP], 1u);
            const unsigned tg = og / nx;
            if (og + 1u == (tg + 1u) * nx) xb_add(&bar[XB_TOPGEN], 1u);
            else XB_SPIN(xb_ld(&bar[XB_TOPGEN]) == tg, bar);
            __builtin_amdgcn_fence(__ATOMIC_ACQUIRE, "agent");
            xb_add(&bar[XB_XGEN(b.x)], 1u);
            asm volatile("s_waitcnt vmcnt(0)" ::: "memory");
        } else {
            XB_SPIN(xb_ld(&bar[XB_XGEN(b.x)]) == gen, bar);
            __builtin_amdgcn_fence(__ATOMIC_ACQUIRE, "agent");
            asm volatile("s_waitcnt vmcnt(0)" ::: "memory");
        }
    }
    __syncthreads();
}
constexpr int NWAVES = 8;
constexpr int BATCH = 4, SEQ = 8192, DM = 2048, DIN = 8192, M = BATCH * SEQ;
constexpr int HG_HEADS = 8, HG_D = 128, AT_HEADS = 16, AT_D = 64;
constexpr int ZC_QH = 0, ZC_FH = 1024, ZC_IH = 2048, ZC_GH = 3072, ZC_QA = 4096, ZC_KA = 5120, ZC_VA = 6144, ZC_GA = 7168;
constexpr float NORM_EPS = 1e-6f;
constexpr size_t MiB = 1u << 20;
constexpr size_t WS_CTL = 0, CTL_ZERO_BYTES = 1 * MiB;
constexpr size_t WS_WIN = 2 * MiB;
constexpr size_t WS_WOUT = 34 * MiB;
constexpr size_t WS_XN = 64 * MiB;
constexpr size_t WS_Y = 192 * MiB;
constexpr size_t WS_Z = 320 * MiB;
constexpr size_t WS_END = 832 * MiB;
constexpr int CW_BAR = 4096;
constexpr int RING_OFF = 0, RING_BYTES = 131072;
constexpr int LDSCTL_OFF = RING_BYTES, MISC_OFF = LDSCTL_OFF + 320;
constexpr int LDS_BYTES = 147456;
__device__ __forceinline__ float wave_sum(float v) {
#pragma unroll
    for (int o = 1; o < 64; o <<= 1) v += __shfl_xor(v, o);
    return v;
}
__device__ __forceinline__ float bflo(unsigned w) { return __uint_as_float(w << 16); }
__device__ __forceinline__ float bfhi(unsigned w) { return __uint_as_float(w & 0xffff0000u); }
__device__ __forceinline__ float bf2f(bf16 v) { return __uint_as_float((unsigned)v << 16); }
__device__ __forceinline__ float silu_f(float x) { return x / (1.f + __expf(-x)); }
__device__ __forceinline__ float sigmoid_f(float x) { return 1.f / (1.f + __expf(-x)); }

__device__ __forceinline__ void p0_transpose_item(const float* W, int K, int N, bf16* WT, LAS float* scr, int item, int lane) {
    const int nblk = N / 32, kb = item / nblk, nb = item % nblk, k0 = 64 * kb, n0 = 32 * nb;
#pragma unroll 8
    for (int i = 0; i < 32; ++i) { const int kk = 2 * i + (lane >> 5); scr[kk * 33 + (lane & 31)] = W[(size_t)(k0 + kk) * N + n0 + (lane & 31)]; }
    LDS_WAIT(); asm volatile("" ::: "memory");
    const int c = lane & 7;
#pragma unroll
    for (int j = 0; j < 4; ++j) { const int n = (lane >> 3) + 8 * j; const LAS float* s = scr + (8 * c) * 33 + n;
        v4u o; o.x = pk2(s[0 * 33], s[1 * 33]); o.y = pk2(s[2 * 33], s[3 * 33]); o.z = pk2(s[4 * 33], s[5 * 33]); o.w = pk2(s[6 * 33], s[7 * 33]);
        *(GAS v4u*)(WT + (size_t)(n0 + n) * K + k0 + 8 * c) = o; }
    LDS_WAIT(); asm volatile("" ::: "memory");
}
__device__ __forceinline__ void rms_row_to_bf16(const float* xrow, const float* gain, bf16* orow, int lane) {
    const GAS f32x4* xr = (const GAS f32x4*)xrow + lane; const GAS f32x4* gr = (const GAS f32x4*)gain + lane;
    f32x4 v[8]; float s = 0.f;
#pragma unroll
    for (int j = 0; j < 8; ++j) { v[j] = xr[64 * j]; s += (v[j].x * v[j].x + v[j].y * v[j].y) + (v[j].z * v[j].z + v[j].w * v[j].w); }
    const float rstd = 1.f / sqrtf(wave_sum(s) * (1.f / DM) + NORM_EPS);
    GAS unsigned long long* o8 = (GAS unsigned long long*)orow + lane;
#pragma unroll
    for (int j = 0; j < 8; ++j) { const f32x4 g = gr[64 * j];
        o8[64 * j] = (unsigned long long)pk2(v[j].x * rstd * g.x, v[j].y * rstd * g.y) | ((unsigned long long)pk2(v[j].z * rstd * g.z, v[j].w * rstd * g.w) << 32); }
}
__device__ __forceinline__ void rms_row_inplace(float* row, const float* gain, int lane) {
    GAS f32x4* xr = (GAS f32x4*)row + lane; const GAS f32x4* gr = (const GAS f32x4*)gain + lane;
    f32x4 v[8]; float s = 0.f;
#pragma unroll
    for (int j = 0; j < 8; ++j) { v[j] = xr[64 * j]; s += (v[j].x * v[j].x + v[j].y * v[j].y) + (v[j].z * v[j].z + v[j].w * v[j].w); }
    const float rstd = 1.f / sqrtf(wave_sum(s) * (1.f / DM) + NORM_EPS);
#pragma unroll
    for (int j = 0; j < 8; ++j) { const f32x4 g = gr[64 * j]; xr[64 * j] = v[j] * rstd * g; }
}

__device__ __forceinline__ void attn_naive_item(const bf16* Z, bf16* Y, int item, int tid) {
    const int blk = item & 15, h = (item >> 4) & 15, b = item >> 8;
    const int t = blk * 512 + tid;
    const bf16* zb = Z + (size_t)b * SEQ * DIN;
    float q[64], acc[64];
    { const uint4* qp = (const uint4*)(zb + (size_t)t * DIN + ZC_QA + h * 64);
#pragma unroll
      for (int c = 0; c < 8; ++c) { const uint4 w = qp[c]; q[8*c+0] = bflo(w.x); q[8*c+1] = bfhi(w.x); q[8*c+2] = bflo(w.y); q[8*c+3] = bfhi(w.y); q[8*c+4] = bflo(w.z); q[8*c+5] = bfhi(w.z); q[8*c+6] = bflo(w.w); q[8*c+7] = bfhi(w.w); } }
#pragma unroll
    for (int e = 0; e < 64; ++e) acc[e] = 0.f;
    float m = -INFINITY, l = 0.f;
    const float slope = exp2f(-0.5f * (float)(h + 1));
    for (int p = 0; p < 3; ++p) {
        const int d = (p == 0) ? 1 : ((p == 1) ? 4 : 16);
        for (int j = 0; j <= 128; ++j) {
            const int tk = t - d * j; if (tk < 0) break;
            const uint4* kp = (const uint4*)(zb + (size_t)tk * DIN + ZC_KA + h * 64);
            float s = 0.f;
#pragma unroll
            for (int c = 0; c < 8; ++c) { const uint4 w = kp[c];
                s += q[8*c+0] * bflo(w.x) + q[8*c+1] * bfhi(w.x) + q[8*c+2] * bflo(w.y) + q[8*c+3] * bfhi(w.y) + q[8*c+4] * bflo(w.z) + q[8*c+5] * bfhi(w.z) + q[8*c+6] * bflo(w.w) + q[8*c+7] * bfhi(w.w); }
            s = s * 0.125f - slope * (float)(d * j);
            const float mn = fmaxf(m, s); const float a = __expf(m - mn), pe = __expf(s - mn);
            l = l * a + pe; m = mn;
            const uint4* vp = (const uint4*)(zb + (size_t)tk * DIN + ZC_VA + h * 64);
#pragma unroll
            for (int c = 0; c < 8; ++c) { const uint4 w = vp[c];
                acc[8*c+0] = acc[8*c+0] * a + pe * bflo(w.x); acc[8*c+1] = acc[8*c+1] * a + pe * bfhi(w.x); acc[8*c+2] = acc[8*c+2] * a + pe * bflo(w.y); acc[8*c+3] = acc[8*c+3] * a + pe * bfhi(w.y);
                acc[8*c+4] = acc[8*c+4] * a + pe * bflo(w.z); acc[8*c+5] = acc[8*c+5] * a + pe * bfhi(w.z); acc[8*c+6] = acc[8*c+6] * a + pe * bflo(w.w); acc[8*c+7] = acc[8*c+7] * a + pe * bfhi(w.w); }
        }
    }
    const float inv = 1.f / l;
    const uint4* gp = (const uint4*)(zb + (size_t)t * DIN + ZC_GA + h * 64);
    uint4* yp = (uint4*)(Y + ((size_t)b * SEQ + t) * DM + 1024 + h * 64);
#pragma unroll
    for (int c = 0; c < 8; ++c) { const uint4 w = gp[c]; uint4 o;
        o.x = pk2(acc[8*c+0] * inv * silu_f(bflo(w.x)), acc[8*c+1] * inv * silu_f(bfhi(w.x)));
        o.y = pk2(acc[8*c+2] * inv * silu_f(bflo(w.y)), acc[8*c+3] * inv * silu_f(bfhi(w.y)));
        o.z = pk2(acc[8*c+4] * inv * silu_f(bflo(w.z)), acc[8*c+5] * inv * silu_f(bfhi(w.z)));
        o.w = pk2(acc[8*c+6] * inv * silu_f(bflo(w.w)), acc[8*c+7] * inv * silu_f(bfhi(w.w)));
        yp[c] = o; }
}

__device__ __forceinline__ void hgrn_naive_item(const bf16* Z, bf16* Y, const float* lb_logits, const float* gnorm, LAS unsigned char* lds, int item, int tid) {
    const int h = item & 7, b = item >> 3;
    LAS float* Fs = (LAS float*)lds; LAS float* Qs = Fs + 4096; LAS float* Vs = Qs + 4096; LAS float* OP = Vs + 4096;
    const int dv = tid & 127, kq = tid >> 7;
    float S[32];
#pragma unroll
    for (int i = 0; i < 32; ++i) S[i] = 0.f;
    const int ch = h * 128 + (tid & 127);
    const float lbd = 1.f / (1.f + __expf(lb_logits[1024 + ch] - lb_logits[ch]));
    const bf16* zb = Z + (size_t)b * SEQ * DIN;
    for (int chunk = 0; chunk < SEQ / 32; ++chunk) {
#pragma unroll
        for (int i = 0; i < 8; ++i) { const int e = tid + 512 * i, tok = e >> 7; const bf16* zr = zb + (size_t)(chunk * 32 + tok) * DIN + ch;
            const float qp = bf2f(zr[ZC_QH]), fp = bf2f(zr[ZC_FH]), vv = bf2f(zr[ZC_IH]);
            Qs[e] = silu_f(qp); Fs[e] = lbd + (1.f - lbd) * sigmoid_f(fp); Vs[e] = vv; }
        __syncthreads();
        for (int tt = 0; tt < 32; ++tt) {
            const float v = Vs[tt * 128 + dv]; float o = 0.f;
#pragma unroll
            for (int i = 0; i < 32; ++i) { const float f = Fs[tt * 128 + kq * 32 + i]; S[i] = f * S[i] + (1.f - f) * v; o += S[i] * Qs[tt * 128 + kq * 32 + i]; }
            OP[(tt * 4 + kq) * 128 + dv] = o;
        }
        __syncthreads();
        { const int tok = tid >> 4, sub = tid & 15; float o[8]; float ssq = 0.f;
#pragma unroll
          for (int e = 0; e < 8; ++e) { const int dvv = sub * 8 + e; o[e] = (OP[(tok * 4 + 0) * 128 + dvv] + OP[(tok * 4 + 1) * 128 + dvv]) + (OP[(tok * 4 + 2) * 128 + dvv] + OP[(tok * 4 + 3) * 128 + dvv]); ssq += o[e] * o[e]; }
          ssq += __shfl_xor(ssq, 1); ssq += __shfl_xor(ssq, 2); ssq += __shfl_xor(ssq, 4); ssq += __shfl_xor(ssq, 8);
          const float rstd = 1.f / sqrtf(ssq * (1.f / 128.f) + NORM_EPS);
          const size_t row = (size_t)b * SEQ + chunk * 32 + tok;
          const uint4 gw = *(const uint4*)(Z + row * DIN + ZC_GH + h * 128 + sub * 8);
          const float* gn = gnorm + sub * 8;
          uint4 w;
          w.x = pk2(o[0] * rstd * gn[0] * silu_f(bflo(gw.x)), o[1] * rstd * gn[1] * silu_f(bfhi(gw.x)));
          w.y = pk2(o[2] * rstd * gn[2] * silu_f(bflo(gw.y)), o[3] * rstd * gn[3] * silu_f(bfhi(gw.y)));
          w.z = pk2(o[4] * rstd * gn[4] * silu_f(bflo(gw.z)), o[5] * rstd * gn[5] * silu_f(bfhi(gw.z)));
          w.w = pk2(o[6] * rstd * gn[6] * silu_f(bflo(gw.w)), o[7] * rstd * gn[7] * silu_f(bfhi(gw.w)));
          *(uint4*)(Y + row * DM + h * 128 + sub * 8) = w; }
        __syncthreads();
    }
}

struct Args { const float* x; const float* norm_gain; const float* w_in; const float* lb_logits; const float* hgrn_gnorm; const float* w_out; const float* final_gain; float* out; unsigned char* ws; };
__global__ void __launch_bounds__(NWAVES * 64, 2) fwd_kernel(Args a) {
    __shared__ __attribute__((aligned(16))) unsigned char lds_raw[LDS_BYTES];
    LAS unsigned char* lds = (LAS unsigned char*)lds_raw;
    volatile LAS unsigned* MISC = (volatile LAS unsigned*)(lds + MISC_OFF);
    const int tid = threadIdx.x, lane = tid & 63, wave = __builtin_amdgcn_readfirstlane(tid >> 6);
    const int G = gridDim.x; const int bx = blockIdx.x; const int vcu = (G % 8 == 0) ? (bx % 8) * (G / 8) + bx / 8 : bx;
    unsigned char* ws = a.ws;
    gu32* ctl = (gu32*)(ws + WS_CTL);
    bf16* WIN_T = (bf16*)(ws + WS_WIN); bf16* WOUT_T = (bf16*)(ws + WS_WOUT); bf16* XN = (bf16*)(ws + WS_XN); bf16* Y = (bf16*)(ws + WS_Y); bf16* Z = (bf16*)(ws + WS_Z);
    for (int u = tid; u < (LDS_BYTES - LDSCTL_OFF) / 4; u += NWAVES * 64) ((LAS unsigned*)(lds + LDSCTL_OFF))[u] = 0u;
    __syncthreads();
    XcdBarrier bar = xcd_barrier_post((unsigned*)(ctl + CW_BAR), MISC + 8);
    const int gw = vcu * NWAVES + wave, NGW = G * NWAVES;

    {
        LAS float* scr = (LAS float*)(lds + RING_OFF + wave * 16384);
        constexpr int I_IN = (DM / 64) * (DIN / 32), I_OUT = (DM / 64) * (DM / 32);
        for (int it = gw; it < I_IN + I_OUT; it += NGW) {
            if (it < I_IN) p0_transpose_item(a.w_in, DM, DIN, WIN_T, scr, it, lane);
            else p0_transpose_item(a.w_out, DM, DM, WOUT_T, scr, it - I_IN, lane);
        }
        for (int m = gw; m < M; m += NGW) rms_row_to_bf16(a.x + (size_t)m * DM, a.norm_gain, XN + (size_t)m * DM, lane);
    }
    xcd_barrier(bar);
    {
        pg8::Gemm g{XN, WIN_T, M, DIN, DM}; pg8::StaticOrder S; S.init(M, DIN, G, bx);
        pg8::EpiBf16 E{Z, DIN};
        pg8::gemm_phase<pg8::EpiBf16, pg8::StaticOrder, true, true>(lds + RING_OFF, g, S, E);
    }
    xcd_barrier(bar);
    {
        if (vcu < 32) hgrn_naive_item(Z, Y, a.lb_logits, a.hgrn_gnorm, lds + RING_OFF, vcu, tid);
        else for (int it = vcu - 32; it < BATCH * AT_HEADS * 16; it += G - 32) attn_naive_item(Z, Y, it, tid);
    }
    xcd_barrier(bar);
    {
        pg8::Gemm g{Y, WOUT_T, M, DM, DM}; pg8::StaticOrder S; S.init(M, DM, G, bx);
        pg8::EpiResF32 E{a.x, a.out, DM};
        pg8::gemm_phase<pg8::EpiResF32, pg8::StaticOrder, true, true>(lds + RING_OFF, g, S, E);
    }
    xcd_barrier(bar);
    for (int m = gw; m < M; m += NGW) rms_row_inplace(a.out + (size_t)m * DM, a.final_gain, lane);
}

extern "C" void kernel_launch(void* const* d_in, const int* in_sizes, int n_in, void* d_out, int out_size, void* d_ws, size_t ws_size, hipStream_t stream) {
    static int grid = 0;
    if (grid == 0) {
        if (n_in != 7 || in_sizes[0] != M * DM || out_size != M * DM || ws_size < WS_END) { fprintf(stderr, "kernel_launch: unexpected shapes (n_in %d in0 %d out %d ws %zu)\n", n_in, n_in > 0 ? in_sizes[0] : -1, out_size, ws_size); grid = -1; return; }
        int dev = 0, cus = 0;
        if (hipGetDevice(&dev) != hipSuccess || hipDeviceGetAttribute(&cus, hipDeviceAttributeMultiprocessorCount, dev) != hipSuccess) { grid = -1; return; }
        grid = cus;
    }
    if (grid < 0) return;
    (void)hipMemsetAsync((char*)d_ws + WS_CTL, 0, CTL_ZERO_BYTES, stream);
    Args a{};
    a.x = (const float*)d_in[0]; a.norm_gain = (const float*)d_in[1]; a.w_in = (const float*)d_in[2]; a.lb_logits = (const float*)d_in[3];
    a.hgrn_gnorm = (const float*)d_in[4]; a.w_out = (const float*)d_in[5]; a.final_gain = (const float*)d_in[6];
    a.out = (float*)d_out; a.ws = (unsigned char*)d_ws;
    hipLaunchKernelGGL(fwd_kernel, dim3(grid), dim3(NWAVES * 64), 0, stream, a);
}
```

```cpp
#include <hip/hip_runtime.h>
#include <cstdio>
#include <cstdint>
namespace pg8 {
#define PG8_LAS __attribute__((address_space(3)))
typedef unsigned short bf16_t;
typedef short bf16x8 __attribute__((ext_vector_type(8)));
typedef float f32x4 __attribute__((ext_vector_type(4)));
typedef unsigned u32x4 __attribute__((ext_vector_type(4)));
constexpr int BM = 256, BK = 64, HALF = 128, HTB = HALF * BK * 2  , STAGE_BYTES = 8 * HTB, NXCD = 8, WGM = 8;

__host__ __device__ __forceinline__ int lds_byte(int r, int c) { const int st = (r >> 4) * 2 + (c >> 5), rr = r & 15, cc = c & 31, ob = rr * 64 + cc * 2; return st * 1024 + (ob ^ (((ob >> 9) & 1) << 5)); }
__host__ __device__ __forceinline__ void stage_rc(int b, int& R, int& C) { const int st = b / 1024, sb = b % 1024, swz = sb ^ (((sb >> 9) & 1) << 5); R = (st >> 1) * 16 + swz / 64; C = (st & 1) * 32 + (swz % 64) / 2; }
__host__ __device__ __forceinline__ int perm32(int rho) { const int n = rho >> 4, i = rho & 15; return 8 * (i >> 2) + 4 * n + (i & 3); }

struct Unit { int pm, pn; };
struct Gemm { const bf16_t* A; const bf16_t* Bt; int M, N, K; };

struct StaticOrder {
    int nM, nN, nwg, G, c;
    __host__ __device__ void init(int M, int N, int G_, int c_) { nM = M / BM; nN = N / BM; nwg = nM * nN; G = G_; c = c_; }
    __host__ __device__ bool next(int i, Unit& u) const {
        const long L = (long)i * G + c; if (L >= nwg) return false;
        int wgid = (int)L; { const int q = nwg / NXCD, r = nwg % NXCD, xcd = wgid % NXCD, off = wgid / NXCD; wgid = (xcd < r ? xcd * (q + 1) : r * (q + 1) + (xcd - r) * q) + off; }
        const int nig = WGM * nN, gid = wgid / nig, fm = gid * WGM, gsz = (nM - fm) < WGM ? (nM - fm) : WGM;
        u.pm = fm + ((wgid % nig) % gsz); u.pn = (wgid % nig) / gsz; return true;
    }
    __device__ __forceinline__ void a_ready(const Unit&) const {}
    __device__ __forceinline__ void done(const Unit&) const {}
};

__device__ __forceinline__ unsigned cvt_pk_bf16(float lo, float hi) { unsigned r; asm volatile("v_cvt_pk_bf16_f32 %0, %1, %2" : "=v"(r) : "v"(lo), "v"(hi)); return r; }
typedef float f32x2 __attribute__((ext_vector_type(2)));
struct EpiBf16 {
    static constexpr bool PERM = true, AFTER_DRAIN = false;
    bf16_t* O; int ldc;
    __device__ __forceinline__ void operator()(const f32x4 (&acc)[2][2][4][2], const Unit& u, int wr, int wc, int fr, int fq) const {
        const int row0 = u.pm * BM + wr * 64 + fr; const int col0 = u.pn * BM + wc * 32 + 8 * fq;
#pragma unroll
        for (int ai = 0; ai < 2; ++ai)
#pragma unroll
            for (int m = 0; m < 4; ++m) { bf16_t* rowp = O + (size_t)(row0 + ai * HALF + m * 16) * ldc + col0;
#pragma unroll
                for (int bj = 0; bj < 2; ++bj) { const f32x4 v0 = acc[ai][bj][m][0], v1 = acc[ai][bj][m][1];
                    u32x4 w; w.x = cvt_pk_bf16(v0[0], v0[1]); w.y = cvt_pk_bf16(v0[2], v0[3]); w.z = cvt_pk_bf16(v1[0], v1[1]); w.w = cvt_pk_bf16(v1[2], v1[3]);
                    *(u32x4*)(rowp + bj * HALF) = w; } }
    }
};
struct EpiResF32 {
    static constexpr bool PERM = false, AFTER_DRAIN = false;
    const float* base; float* C; int ldc;
    __device__ __forceinline__ void operator()(const f32x4 (&acc)[2][2][4][2], const Unit& u, int wr, int wc, int fr, int fq) const {
        const int row0 = u.pm * BM + wr * 64 + fr, col0 = u.pn * BM + wc * 32 + 4 * fq;
#pragma unroll
        for (int ai = 0; ai < 2; ++ai)
#pragma unroll
            for (int m = 0; m < 4; ++m) { const size_t off = (size_t)(row0 + ai * HALF + m * 16) * ldc + col0;
#pragma unroll
                for (int bj = 0; bj < 2; ++bj)
#pragma unroll
                    for (int n = 0; n < 2; ++n) *(f32x4*)(C + off + bj * HALF + n * 16) = *(const f32x4*)(base + off + bj * HALF + n * 16) + acc[ai][bj][m][n]; }
    }
};
template <class Epi, class Sched, bool ALIGN_EPI = false, bool SP2 = false>
__device__ __forceinline__ void gemm_phase(PG8_LAS unsigned char* lds, const Gemm g, const Sched& S, const Epi& E) {
    const int tid = threadIdx.x, wid = __builtin_amdgcn_readfirstlane(tid >> 6), lane = tid & 63, wr = wid >> 2, wc = wid & 3, fr = lane & 15, fq = lane >> 4;
    const int K = g.K, nt = K / BK;
    unsigned voffA[2], voffB[2];
#pragma unroll
    for (int i = 0; i < 2; ++i) { int R, C; stage_rc(tid * 16 + i * 8192, R, C); const int Rb = Epi::PERM ? ((R & ~31) + perm32(R & 31)) : R;
        voffA[i] = (unsigned)(R * K + C) * 2u; voffB[i] = (unsigned)(Rb * K + C) * 2u; }
    const size_t kstep = (size_t)(BK * 2);
    const size_t hstep = (size_t)HALF * K * 2;
    const size_t tstep = 2 * hstep;
    const unsigned ldsw = (unsigned)wid * 1024u;
    const int aoff = lds_byte(wr * 64 + fr, fq * 8), boff = lds_byte(wc * 32 + fr, fq * 8);
#define PG8_SA(b, h) (((b) * 2 + (h)) * HTB)
#define PG8_SB(b, h) ((4 + (b) * 2 + (h)) * HTB)
#define PG8_STAGE(bufoff, gbase, voff) do { _Pragma("unroll") for (int _i = 0; _i < 2; ++_i) \
        __builtin_amdgcn_global_load_lds((const unsigned*)((const char*)(gbase) + (voff)[_i]), (PG8_LAS unsigned*)(lds + (bufoff) + ldsw + _i * 8192), 16, 0, 0); } while (0)
#define PG8_LDA(dst, b, h) do { _Pragma("unroll") for (int m = 0; m < 4; ++m) _Pragma("unroll") for (int k = 0; k < 2; ++k) dst[m][k] = *(const PG8_LAS bf16x8*)(lds + PG8_SA(b, h) + aoff + m * 2048 + k * 1024); } while (0)
#define PG8_LDB(dst, b, h) do { _Pragma("unroll") for (int n = 0; n < 2; ++n) _Pragma("unroll") for (int k = 0; k < 2; ++k) dst[n][k] = *(const PG8_LAS bf16x8*)(lds + PG8_SB(b, h) + boff + n * 2048 + k * 1024); } while (0)
#define PG8_MMA(ai, bj, At, Bt) do { __builtin_amdgcn_s_setprio(1); _Pragma("unroll") for (int m = 0; m < 4; ++m) _Pragma("unroll") for (int n = 0; n < 2; ++n) _Pragma("unroll") for (int k = 0; k < 2; ++k) \
        acc[ai][bj][m][n] = __builtin_amdgcn_mfma_f32_16x16x32_bf16(Bt[n][k], At[m][k], acc[ai][bj][m][n], 0, 0, 0); __builtin_amdgcn_s_setprio(0); } while (0)
#define PG8_WAIT_V(n) asm volatile("s_waitcnt vmcnt(" #n ")" ::: "memory")
#define PG8_WAIT_L(n) asm volatile("s_waitcnt lgkmcnt(" #n ")" ::: "memory")
#define PG8_BAR __builtin_amdgcn_s_barrier()
#define PG8_SCHED __builtin_amdgcn_sched_barrier(0)
    Unit cur, nxt; int ui = 0;
    if (!S.next(0, cur)) return;
    f32x4 acc[2][2][4][2];
#pragma unroll
    for (int a = 0; a < 2; ++a)
#pragma unroll
        for (int b = 0; b < 2; ++b)
#pragma unroll
            for (int m = 0; m < 4; ++m)
#pragma unroll
                for (int n = 0; n < 2; ++n) acc[a][b][m][n] = (f32x4){0.f, 0.f, 0.f, 0.f};
    bf16x8 At[4][2], B0[2][2], B1[2][2];
    const char* cA = (const char*)g.A + (size_t)cur.pm * tstep; const char* cB = (const char*)g.Bt + (size_t)cur.pn * tstep;
    S.a_ready(cur);
    if constexpr (SP2) {
        PG8_STAGE(PG8_SB(0, 0), cB, voffB); PG8_STAGE(PG8_SB(0, 1), cB + hstep, voffB); PG8_STAGE(PG8_SA(0, 0), cA, voffA); PG8_STAGE(PG8_SA(0, 1), cA + hstep, voffA);
        if (wr == 1) PG8_BAR;
        PG8_WAIT_V(2); PG8_BAR;
        PG8_STAGE(PG8_SB(1, 0), cB + kstep, voffB); PG8_STAGE(PG8_SA(1, 0), cA + kstep, voffA); PG8_STAGE(PG8_SB(1, 1), cB + hstep + kstep, voffB);
        PG8_WAIT_V(6); PG8_BAR;
    } else {
        PG8_STAGE(PG8_SB(0, 0), cB, voffB); PG8_STAGE(PG8_SA(0, 0), cA, voffA); PG8_STAGE(PG8_SB(0, 1), cB + hstep, voffB); PG8_STAGE(PG8_SA(0, 1), cA + hstep, voffA);
        if (wr == 1) PG8_BAR;
        PG8_WAIT_V(4); PG8_BAR;
        PG8_STAGE(PG8_SB(1, 0), cB + kstep, voffB); PG8_STAGE(PG8_SA(1, 0), cA + kstep, voffA); PG8_STAGE(PG8_SB(1, 1), cB + hstep + kstep, voffB);
        PG8_WAIT_V(6); PG8_BAR;
    }
    for (;;) {
        const bool has_next = S.next(ui + 1, nxt);
        const char* nA = has_next ? (const char*)g.A + (size_t)nxt.pm * tstep : cA; const char* nB = has_next ? (const char*)g.Bt + (size_t)nxt.pn * tstep : cB;
        for (int t = 0; t < nt; t += 2) {
            const bool last = (t == nt - 2);
            const char* a1 = cA + (size_t)(t + 1) * kstep;
            const char* a2 = last ? nA : cA + (size_t)(t + 2) * kstep; const char* b2 = last ? nB : cB + (size_t)(t + 2) * kstep;
            const char* a3 = a2 + kstep; const char* b3 = b2 + kstep;
            if (last && has_next) S.a_ready(nxt);
            if constexpr (SP2) {
            PG8_LDB(B0, 0, 0); PG8_LDB(B1, 0, 1); PG8_SCHED; PG8_LDA(At, 0, 0); PG8_STAGE(PG8_SA(1, 1), a1 + hstep, voffA);
            PG8_WAIT_V(8); PG8_WAIT_L(0); PG8_BAR; PG8_MMA(0, 0, At, B0); PG8_MMA(0, 1, At, B1); PG8_BAR; PG8_SCHED;
            PG8_LDA(At, 0, 1); PG8_STAGE(PG8_SB(0, 0), b2, voffB); PG8_STAGE(PG8_SB(0, 1), b2 + hstep, voffB); PG8_STAGE(PG8_SA(0, 0), a2, voffA);
            PG8_WAIT_V(8); PG8_WAIT_L(0); PG8_BAR; PG8_MMA(1, 0, At, B0); PG8_MMA(1, 1, At, B1); PG8_BAR; PG8_SCHED;
            PG8_LDB(B0, 1, 0); PG8_LDB(B1, 1, 1); PG8_SCHED; PG8_LDA(At, 1, 0); PG8_STAGE(PG8_SA(0, 1), a2 + hstep, voffA);
            PG8_WAIT_V(8); PG8_WAIT_L(0); PG8_BAR; PG8_MMA(0, 0, At, B0); PG8_MMA(0, 1, At, B1); PG8_BAR; PG8_SCHED;
            PG8_LDA(At, 1, 1); PG8_STAGE(PG8_SB(1, 0), b3, voffB); PG8_STAGE(PG8_SB(1, 1), b3 + hstep, voffB); PG8_STAGE(PG8_SA(1, 0), a3, voffA);
            PG8_WAIT_V(8); PG8_WAIT_L(0); PG8_BAR; PG8_MMA(1, 0, At, B0); PG8_MMA(1, 1, At, B1); PG8_BAR; PG8_SCHED;
            } else {
            PG8_LDB(B0, 0, 0); PG8_SCHED; PG8_LDA(At, 0, 0); PG8_STAGE(PG8_SA(1, 1), a1 + hstep, voffA);
            PG8_WAIT_L(8); PG8_BAR; PG8_WAIT_L(0); PG8_MMA(0, 0, At, B0); PG8_BAR; PG8_SCHED;
            PG8_LDB(B1, 0, 1); PG8_STAGE(PG8_SB(0, 0), b2, voffB);
            PG8_BAR; PG8_WAIT_L(0); PG8_MMA(0, 1, At, B1); PG8_BAR;
            PG8_LDA(At, 0, 1); PG8_STAGE(PG8_SA(0, 0), a2, voffA);
            PG8_BAR; PG8_WAIT_L(0); PG8_MMA(1, 0, At, B0); PG8_BAR; PG8_SCHED;
            PG8_STAGE(PG8_SB(0, 1), b2 + hstep, voffB);
            PG8_WAIT_V(6); PG8_BAR; PG8_MMA(1, 1, At, B1); PG8_BAR;
            PG8_LDB(B0, 1, 0); PG8_SCHED; PG8_LDA(At, 1, 0); PG8_STAGE(PG8_SA(0, 1), a2 + hstep, voffA);
            PG8_WAIT_L(8); PG8_BAR; PG8_WAIT_L(0); PG8_MMA(0, 0, At, B0); PG8_BAR; PG8_SCHED;
            PG8_LDB(B1, 1, 1); PG8_STAGE(PG8_SB(1, 0), b3, voffB);
            PG8_BAR; PG8_WAIT_L(0); PG8_MMA(0, 1, At, B1); PG8_BAR;
            PG8_LDA(At, 1, 1); PG8_STAGE(PG8_SA(1, 0), a3, voffA);
            PG8_BAR; PG8_WAIT_L(0); PG8_MMA(1, 0, At, B0); PG8_BAR; PG8_SCHED;
            PG8_STAGE(PG8_SB(1, 1), b3 + hstep, voffB);
            PG8_WAIT_V(6); PG8_BAR; PG8_MMA(1, 1, At, B1); PG8_BAR;
            }
        }
        if constexpr (ALIGN_EPI) { if (wr == 0) PG8_BAR; }
        if constexpr (!Epi::AFTER_DRAIN) { E(acc, cur, wr, wc, fr, fq); S.done(cur); }
        if (!has_next) break;
#pragma unroll
        for (int a = 0; a < 2; ++a)
#pragma unroll
            for (int b = 0; b < 2; ++b)
#pragma unroll
                for (int m = 0; m < 4; ++m)
#pragma unroll
                    for (int n = 0; n < 2; ++n) acc[a][b][m][n] = (f32x4){0.f, 0.f, 0.f, 0.f};
        cur = nxt; cA = nA; cB = nB; ++ui;
        if constexpr (ALIGN_EPI) { if (wr == 1) PG8_BAR; }
    }
    PG8_WAIT_V(0);
    if constexpr (!ALIGN_EPI) { if (wr == 0) PG8_BAR; }
    PG8_BAR;
    if constexpr (Epi::AFTER_DRAIN) { E.fused(acc, cur, wr, wc, fr, fq, lds, wid, lane); S.done(cur); }
#undef PG8_SA
#undef PG8_SB
#undef PG8_STAGE
#undef PG8_LDA
#undef PG8_LDB
#undef PG8_MMA
#undef PG8_WAIT_V
#undef PG8_WAIT_L
#undef PG8_BAR
#undef PG8_SCHED
}
}
#define GAS __attribute__((address_space(1)))
#define LAS __attribute__((address_space(3)))
typedef unsigned short bf16;
typedef unsigned v4u __attribute__((ext_vector_type(4)));
typedef float f32x4 __attribute__((ext_vector_type(4)));
typedef short bf16x8 __attribute__((ext_vector_type(8)));
typedef GAS unsigned gu32;
typedef GAS unsigned long long gu64;
#define RLX_AGENT __ATOMIC_RELAXED, __HIP_MEMORY_SCOPE_AGENT
#define LDS_WAIT() asm volatile("s_waitcnt lgkmcnt(0)" ::: "memory")
#define VM_WAIT() asm volatile("s_waitcnt vmcnt(0)" ::: "memory")
__device__ __forceinline__ unsigned long long rt() { return __builtin_amdgcn_s_memrealtime(); }
__device__ __forceinline__ unsigned f2bf(float f) { unsigned u = __builtin_bit_cast(unsigned, f); return (u + 0x7fffu + ((u >> 16) & 1u)) >> 16; }
__device__ __forceinline__ unsigned pk2(float lo, float hi) { return f2bf(lo) | (f2bf(hi) << 16); }
#define XB_TMO      128
#define XB_XCNT(j)  (256  + 64 * (j))
#define XB_XSUB(j)  (1280 + 64 * (j))
#define XB_XGEN(j)  (2304 + 64 * (j))
#define XB_TOP      3328
#define XB_TOPGEN   3392
#define XCD_BAR_WORDS 3456
#define XB_SPIN_CAP (1u << 18)

__device__ __forceinline__ unsigned xb_ld(unsigned* p)              { return __hip_atomic_load(p, __ATOMIC_RELAXED, __HIP_MEMORY_SCOPE_AGENT); }
__device__ __forceinline__ unsigned xb_add(unsigned* p, unsigned v) { return __hip_atomic_fetch_add(p, v, __ATOMIC_RELAXED, __HIP_MEMORY_SCOPE_AGENT); }
__device__ __forceinline__ unsigned xb_xcc_id() { return (unsigned)__builtin_amdgcn_s_getreg((3 << 11) | 20) & 0xFu; }
#define XB_SPIN(cond, bar) do { unsigned _sp = 0; while (cond) { __builtin_amdgcn_s_sleep(1); \
    if ((++_sp & 255u) == 0u) { if (xb_ld(&(bar)[XB_TMO])) break; if (_sp > XB_SPIN_CAP) { atomicAdd(&(bar)[XB_TMO], 1u); break; } } } } while (0)

struct XcdBarrier {
    unsigned* bar; unsigned x;
    volatile LAS unsigned* st;
};

__device__ __forceinline__ XcdBarrier xcd_barrier_post(unsigned* bar, volatile LAS unsigned* st) {
    XcdBarrier b; b.bar = bar; b.x = xb_xcc_id(); b.st = st;
    if (threadIdx.x == 0) (void)xb_add(&bar[XB_XCNT(b.x)], 1u);
    return b;
}
__device__ __forceinline__ void xcd_barrier_complete(unsigned* bar, unsigned x, unsigned& nloc, unsigned& nx) {
    const unsigned G = gridDim.x * gridDim.y * gridDim.z;
    unsigned sum, cnt, mine, sp = 0u;
    for (;;) {
        sum = 0u; cnt = 0u; mine = 0u;
#pragma unroll
        for (unsigned j = 0; j < 16; ++j) { const unsigned c = xb_ld(&bar[XB_XCNT(j)]); sum += c; cnt += (c > 0u) ? 1u : 0u; mine = (j == x) ? c : mine; }
        if (sum == G) break;
        __builtin_amdgcn_s_sleep(1);
        if ((++sp & 255u) == 0u) { if (xb_ld(&bar[XB_TMO])) break; if (sp > XB_SPIN_CAP) { atomicAdd(&bar[XB_TMO], 1u); break; } }
    }
    nloc = mine > 0u ? mine : 1u; nx = cnt > 0u ? cnt : 1u;
}

__device__ __forceinline__ void xcd_barrier(const XcdBarrier& b) {
    asm volatile("s_waitcnt vmcnt(0)" ::: "memory");
    __syncthreads();
    if (threadIdx.x == 0) {
        unsigned* bar = b.bar;
        __builtin_amdgcn_s_waitcnt(0);
        unsigned nloc = b.st[0], nx = b.st[1];
        if (nloc == 0u) { xcd_barrier_complete(bar, b.x, nloc, nx); b.st[0] = nloc; b.st[1] = nx; }
        const unsigned old = xb_add(&bar[XB_XSUB(b.x)], 1u);
        const unsigned gen = old / nloc;
        if (old + 1u == (gen + 1u) * nloc) {
            __builtin_amdgcn_fence(__ATOMIC_RELEASE, "agent");
            asm volatile("s_waitcnt vmcnt(0)" ::: "memory");
            const unsigned og = xb_add(&bar[XB_TOP], 1u);
            const unsigned tg = og / nx;
            if (og + 1u == (tg + 1u) * nx) xb_add(&bar[XB_TOPGEN], 1u);
            else XB_SPIN(xb_ld(&bar[XB_TOPGEN]) == tg, bar);
            __builtin_amdgcn_fence(__ATOMIC_ACQUIRE, "agent");
            xb_add(&bar[XB_XGEN(b.x)], 1u);
            asm volatile("s_waitcnt vmcnt(0)" ::: "memory");
        } else {
            XB_SPIN(xb_ld(&bar[XB_XGEN(b.x)]) == gen, bar);
            __builtin_amdgcn_fence(__ATOMIC_ACQUIRE, "agent");
            asm volatile("s_waitcnt vmcnt(0)" ::: "memory");
        }
    }
    __syncthreads();
}
constexpr int NWAVES = 8;
constexpr int BATCH = 4, SEQ = 8192, DM = 2048, DIN = 8192, M = BATCH * SEQ;
constexpr int HG_HEADS = 8, HG_D = 128, AT_HEADS = 16, AT_D = 64;
constexpr int ZC_QH = 0, ZC_FH = 1024, ZC_IH = 2048, ZC_GH = 3072, ZC_QA = 4096, ZC_KA = 5120, ZC_VA = 6144, ZC_GA = 7168;
constexpr float NORM_EPS = 1e-6f;
constexpr size_t MiB = 1u << 20;
constexpr size_t WS_CTL = 0, CTL_ZERO_BYTES = 1 * MiB;
constexpr size_t WS_WIN = 2 * MiB;
constexpr size_t WS_WOUT = 34 * MiB;
constexpr size_t WS_SLOC = 42 * MiB;
constexpr size_t WS_DSEG = 58 * MiB;
constexpr size_t WS_XN = 64 * MiB;
constexpr size_t WS_Y = 192 * MiB;
constexpr size_t WS_Z = 320 * MiB;
constexpr size_t WS_END = 832 * MiB;
constexpr int CW_BAR = 4096;
constexpr int RING_OFF = 0, RING_BYTES = 131072;
constexpr int LDSCTL_OFF = 155648, MISC_OFF = LDSCTL_OFF + 320;
constexpr int LDS_BYTES = 163840;
__device__ __forceinline__ float wave_sum(float v) {
#pragma unroll
    for (int o = 1; o < 64; o <<= 1) v += __shfl_xor(v, o);
    return v;
}
__device__ __forceinline__ float bflo(unsigned w) { return __uint_as_float(w << 16); }
__device__ __forceinline__ float bfhi(unsigned w) { return __uint_as_float(w & 0xffff0000u); }
__device__ __forceinline__ float bf2f(bf16 v) { return __uint_as_float((unsigned)v << 16); }
__device__ __forceinline__ float silu_f(float x) { return x / (1.f + __expf(-x)); }
__device__ __forceinline__ float sigmoid_f(float x) { return 1.f / (1.f + __expf(-x)); }

__device__ __forceinline__ void p0_transpose_item(const float* W, int K, int N, bf16* WT, LAS float* scr, int item, int lane) {
    const int nblk = N / 32, kb = item / nblk, nb = item % nblk, k0 = 64 * kb, n0 = 32 * nb;
#pragma unroll 8
    for (int i = 0; i < 32; ++i) { const int kk = 2 * i + (lane >> 5); scr[kk * 33 + (lane & 31)] = W[(size_t)(k0 + kk) * N + n0 + (lane & 31)]; }
    LDS_WAIT(); asm volatile("" ::: "memory");
    const int c = lane & 7;
#pragma unroll
    for (int j = 0; j < 4; ++j) { const int n = (lane >> 3) + 8 * j; const LAS float* s = scr + (8 * c) * 33 + n;
        v4u o; o.x = pk2(s[0 * 33], s[1 * 33]); o.y = pk2(s[2 * 33], s[3 * 33]); o.z = pk2(s[4 * 33], s[5 * 33]); o.w = pk2(s[6 * 33], s[7 * 33]);
        *(GAS v4u*)(WT + (size_t)(n0 + n) * K + k0 + 8 * c) = o; }
    LDS_WAIT(); asm volatile("" ::: "memory");
}
__device__ __forceinline__ void rms_row_to_bf16(const float* xrow, const float* gain, bf16* orow, int lane) {
    const GAS f32x4* xr = (const GAS f32x4*)xrow + lane; const GAS f32x4* gr = (const GAS f32x4*)gain + lane;
    f32x4 v[8]; float s = 0.f;
#pragma unroll
    for (int j = 0; j < 8; ++j) { v[j] = xr[64 * j]; s += (v[j].x * v[j].x + v[j].y * v[j].y) + (v[j].z * v[j].z + v[j].w * v[j].w); }
    const float rstd = 1.f / sqrtf(wave_sum(s) * (1.f / DM) + NORM_EPS);
    GAS unsigned long long* o8 = (GAS unsigned long long*)orow + lane;
#pragma unroll
    for (int j = 0; j < 8; ++j) { const f32x4 g = gr[64 * j];
        o8[64 * j] = (unsigned long long)pk2(v[j].x * rstd * g.x, v[j].y * rstd * g.y) | ((unsigned long long)pk2(v[j].z * rstd * g.z, v[j].w * rstd * g.w) << 32); }
}
__device__ __forceinline__ void rms_row_inplace(float* row, const float* gain, int lane) {
    GAS f32x4* xr = (GAS f32x4*)row + lane; const GAS f32x4* gr = (const GAS f32x4*)gain + lane;
    f32x4 v[8]; float s = 0.f;
#pragma unroll
    for (int j = 0; j < 8; ++j) { v[j] = xr[64 * j]; s += (v[j].x * v[j].x + v[j].y * v[j].y) + (v[j].z * v[j].z + v[j].w * v[j].w); }
    const float rstd = 1.f / sqrtf(wave_sum(s) * (1.f / DM) + NORM_EPS);
#pragma unroll
    for (int j = 0; j < 8; ++j) { const f32x4 g = gr[64 * j]; xr[64 * j] = v[j] * rstd * g; }
}

namespace att {
typedef float f32x16 __attribute__((ext_vector_type(16)));
typedef short v4i16_t __attribute__((ext_vector_type(4)));
typedef unsigned u32x4 __attribute__((ext_vector_type(4)));
typedef unsigned u32x2 __attribute__((ext_vector_type(2)));
constexpr int KS = 144, VS = 192, WAVE_BYTES = 32 * KS + 32 * VS;
constexpr int OST_OFF = 8 * WAVE_BYTES, LSE_OFF = OST_OFF + 512 * 128, TOTAL_BYTES = LSE_OFF + 512 * 4;
constexpr float C1 = 0.125f * 1.4426950408889634f;
__device__ __forceinline__ int ost_byte(int tb, int c8) { return tb * 128 + ((((c8 >> 1) ^ (tb ^ (tb >> 4))) & 7) << 4) + ((c8 & 1) << 3); }
__device__ __forceinline__ unsigned cvtpk(float lo, float hi) { unsigned r; asm volatile("v_cvt_pk_bf16_f32 %0, %1, %2" : "=v"(r) : "v"(lo), "v"(hi)); return r; }

template <int DIL, bool FIRST>
__device__ __forceinline__ void tile(const bf16* zb, int h, int tq0, int tb0, int tbs, LAS unsigned char* Kt, LAS unsigned char* Vt, LAS unsigned char* Ost, LAS float* Lse, int lane, float sl2) {
    const int ql = lane & 31, hh = lane >> 5;
    const int u0 = tq0 / DIL;
    const int kt0 = (u0 >= 128) ? 0 : ((128 - u0) >> 5);
    bf16x8 qf[4];
    { const bf16* qp = zb + (size_t)(tq0 + DIL * ql) * DIN + ZC_QA + h * 64 + 8 * hh;
#pragma unroll
      for (int kk = 0; kk < 4; ++kk) qf[kk] = *(const bf16x8*)(qp + 16 * kk); }
    const int lrow = lane >> 3, lch = lane & 7;
    u32x4 kn[4], vn[4];
#define ATT_LOADKV(kt) do { _Pragma("unroll") for (int i_ = 0; i_ < 4; ++i_) { const bf16* rp_ = zb + (size_t)(tq0 + DIL * (32 * (kt) - 128 + 8 * i_ + lrow)) * DIN + h * 64 + lch * 8; \
        kn[i_] = *(const u32x4*)(rp_ + ZC_KA); vn[i_] = *(const u32x4*)(rp_ + ZC_VA); } } while (0)
#define ATT_STOREKV() do { _Pragma("unroll") for (int i_ = 0; i_ < 4; ++i_) { *(LAS u32x4*)(Kt + (8 * i_ + lrow) * KS + lch * 16) = kn[i_]; *(LAS u32x4*)(Vt + (8 * i_ + lrow) * VS + lch * 16) = vn[i_]; } } while (0)
    float m = -INFINITY, l = 0.f;
    f32x16 O0 = {0.f,0.f,0.f,0.f,0.f,0.f,0.f,0.f,0.f,0.f,0.f,0.f,0.f,0.f,0.f,0.f}, O1 = O0;
    const int li = lane & 15, vbase = (4 * hh + (li >> 2)) * VS + (16 * ((lane >> 4) & 1) + 4 * (li & 3)) * 2;
    ATT_LOADKV(kt0); ATT_STOREKV();
#pragma unroll 1
    for (int kt = kt0; kt <= 4; ++kt) {
        if (kt < 4) ATT_LOADKV(kt + 1);
        f32x16 S = {0.f,0.f,0.f,0.f,0.f,0.f,0.f,0.f,0.f,0.f,0.f,0.f,0.f,0.f,0.f,0.f};
#pragma unroll
        for (int kk = 0; kk < 4; ++kk) { const bf16x8 kf = *(const LAS bf16x8*)(Kt + ql * KS + (16 * kk + 8 * hh) * 2); S = __builtin_amdgcn_mfma_f32_32x32x16_bf16(kf, qf[kk], S, 0, 0, 0); }
        const float dbase = (float)(128 - 32 * kt + ql - 4 * hh);
        float sv[16];
#pragma unroll
        for (int r = 0; r < 16; ++r) { const float dl = dbase - (float)((r & 3) + 8 * (r >> 2)); const float v = __builtin_fmaf(-sl2, dl, S[r] * C1); sv[r] = (__builtin_fabsf(dl - 64.f) <= 64.f) ? v : -INFINITY; }
        float rm = sv[0];
#pragma unroll
        for (int r = 1; r < 16; ++r) rm = fmaxf(rm, sv[r]);
        rm = fmaxf(rm, __shfl_xor(rm, 32));
        const float mn = fmaxf(m, rm); const float alpha = __builtin_amdgcn_exp2f(m - mn); m = mn;
        float ps = 0.f;
#pragma unroll
        for (int r = 0; r < 16; ++r) { sv[r] = __builtin_amdgcn_exp2f(sv[r] - mn); ps += sv[r]; }
        l = l * alpha + ps;
        O0 *= alpha; O1 *= alpha;
        u32x4 pw[2];
#pragma unroll
        for (int s = 0; s < 2; ++s) { pw[s].x = cvtpk(sv[8*s+0], sv[8*s+1]); pw[s].y = cvtpk(sv[8*s+2], sv[8*s+3]); pw[s].z = cvtpk(sv[8*s+4], sv[8*s+5]); pw[s].w = cvtpk(sv[8*s+6], sv[8*s+7]); }
#pragma unroll
        for (int s = 0; s < 2; ++s) {
            const bf16x8 pf = __builtin_bit_cast(bf16x8, pw[s]);
#pragma unroll
            for (int dh = 0; dh < 2; ++dh) {
                const v4i16_t a0 = __builtin_amdgcn_ds_read_tr16_b64_v4i16((LAS v4i16_t*)(Vt + vbase + (16 * s) * VS + dh * 64));
                const v4i16_t a1 = __builtin_amdgcn_ds_read_tr16_b64_v4i16((LAS v4i16_t*)(Vt + vbase + (16 * s + 8) * VS + dh * 64));
                const bf16x8 vf = (bf16x8){a0[0], a0[1], a0[2], a0[3], a1[0], a1[1], a1[2], a1[3]};
                if (dh == 0) O0 = __builtin_amdgcn_mfma_f32_32x32x16_bf16(vf, pf, O0, 0, 0, 0); else O1 = __builtin_amdgcn_mfma_f32_32x32x16_bf16(vf, pf, O1, 0, 0, 0);
            }
        }
        asm volatile("" ::: "memory");
        if (kt < 4) ATT_STOREKV();
        asm volatile("" ::: "memory");
    }
#undef ATT_LOADKV
#undef ATT_STOREKV
    const float lt = l + __shfl_xor(l, 32);
    const float lse = m + __builtin_amdgcn_logf(lt);
    const int tb = tb0 + tbs * ql;
    if (FIRST) {
        const float sc = 1.f / lt;
#pragma unroll
        for (int dh = 0; dh < 2; ++dh)
#pragma unroll
            for (int g = 0; g < 4; ++g) { const f32x16& O = dh ? O1 : O0;
                u32x2 w; w.x = cvtpk(O[4*g+0] * sc, O[4*g+1] * sc); w.y = cvtpk(O[4*g+2] * sc, O[4*g+3] * sc);
                *(LAS u32x2*)(Ost + ost_byte(tb, 8 * dh + 2 * g + hh)) = w; }
        if (hh == 0) Lse[tb] = lse;
    } else {
        const float lp = Lse[tb]; const float M = fmaxf(lp, lse); const float wp = __builtin_amdgcn_exp2f(lp - M), wc = __builtin_amdgcn_exp2f(lse - M);
        const float inv = 1.f / (wp + wc); const float a = wp * inv, c = wc * inv / lt;
#pragma unroll
        for (int dh = 0; dh < 2; ++dh)
#pragma unroll
            for (int g = 0; g < 4; ++g) { const f32x16& O = dh ? O1 : O0; LAS u32x2* p = (LAS u32x2*)(Ost + ost_byte(tb, 8 * dh + 2 * g + hh));
                const u32x2 pv = *p; u32x2 w;
                w.x = cvtpk(bflo(pv.x) * a + O[4*g+0] * c, bfhi(pv.x) * a + O[4*g+1] * c); w.y = cvtpk(bflo(pv.y) * a + O[4*g+2] * c, bfhi(pv.y) * a + O[4*g+3] * c);
                *p = w; }
        asm volatile("" ::: "memory");
        if (hh == 0) Lse[tb] = M + __builtin_amdgcn_logf(wp + wc);
    }
}

__device__ __forceinline__ void unit(const bf16* Z, bf16* Y, int item, LAS unsigned char* lds, int tid, int lane, int wave) {
    const int blk = item & 15, h = (item >> 4) & 15, b = item >> 8, T0 = blk * 512;
    const bf16* zb = Z + (size_t)b * SEQ * DIN;
    LAS unsigned char* Kt = lds + wave * WAVE_BYTES; LAS unsigned char* Vt = Kt + 32 * KS;
    LAS unsigned char* Ost = lds + OST_OFF; LAS float* Lse = (LAS float*)(lds + LSE_OFF);
    const float slope2 = exp2f(-0.5f * (float)(h + 1)) * 1.4426950408889634f;
    for (int j = 0; j < 2; ++j) { const int i = wave + 8 * j; tile<16, true>(zb, h, T0 + i, i, 16, Kt, Vt, Ost, Lse, lane, slope2 * 16.f); }
    __syncthreads();
    for (int j = 0; j < 2; ++j) { const int i = wave + 8 * j, r4 = i >> 2, sb = i & 3; tile<4, false>(zb, h, T0 + 128 * sb + r4, 128 * sb + r4, 4, Kt, Vt, Ost, Lse, lane, slope2 * 4.f); }
    __syncthreads();
    for (int j = 0; j < 2; ++j) { const int i = wave + 8 * j; tile<1, false>(zb, h, T0 + 32 * i, 32 * i, 1, Kt, Vt, Ost, Lse, lane, slope2); }
    __syncthreads();
#pragma unroll
    for (int i = 0; i < 8; ++i) { const int idx = tid + 512 * i, tb = idx >> 3, c16 = idx & 7;
        const u32x4 o = *(const LAS u32x4*)(Ost + ost_byte(tb, 2 * c16));
        const size_t row = (size_t)b * SEQ + T0 + tb;
        const uint4 g = *(const uint4*)(Z + row * DIN + ZC_GA + h * 64 + c16 * 8);
        uint4 w;
        w.x = pk2(bflo(o.x) * silu_f(bflo(g.x)), bfhi(o.x) * silu_f(bfhi(g.x))); w.y = pk2(bflo(o.y) * silu_f(bflo(g.y)), bfhi(o.y) * silu_f(bfhi(g.y)));
        w.z = pk2(bflo(o.z) * silu_f(bflo(g.z)), bfhi(o.z) * silu_f(bfhi(g.z))); w.w = pk2(bflo(o.w) * silu_f(bflo(g.w)), bfhi(o.w) * silu_f(bfhi(g.w)));
        *(uint4*)(Y + row * DM + 1024 + h * 64 + c16 * 8) = w; }
    __syncthreads();
}
}
namespace hg {
typedef float f32x16 __attribute__((ext_vector_type(16)));
typedef unsigned u32x4 __attribute__((ext_vector_type(4)));
typedef unsigned u32x2 __attribute__((ext_vector_type(2)));
constexpr int QS = 272, TS = 144;
constexpr int QD_OFF = 0, KD_OFF = 17408, KET_OFF = 34816, VT_OFF = 53248, ST_OFF = 71680, AM_OFF = 106496, DL_OFF = 115712, SS_OFF = 116224, TOTAL_BYTES = 117248;
constexpr int SEGS = 8, SEG_TOK = 1024, CHUNKS = 16;
__device__ __forceinline__ unsigned cvtpk(float lo, float hi) { unsigned r; asm volatile("v_cvt_pk_bf16_f32 %0, %1, %2" : "=v"(r) : "v"(lo), "v"(hi)); return r; }
#define HG_ZERO16 {0.f,0.f,0.f,0.f,0.f,0.f,0.f,0.f,0.f,0.f,0.f,0.f,0.f,0.f,0.f,0.f}

template <bool PASSB>
__device__ __forceinline__ void elementwise(const bf16* zc, LAS unsigned char* lds, int tid, int lane, float lbd, float& dseg) {
    const int c = tid >> 2, tg = tid & 3;
    const bf16* zp = zc + (size_t)(16 * tg) * DIN + c;
    float f[16];
#pragma unroll
    for (int i = 0; i < 16; ++i) { const float fp = bf2f(zp[(size_t)i * DIN + ZC_FH]); f[i] = lbd + (1.f - lbd) * sigmoid_f(fp); }
    float G = f[0];
#pragma unroll
    for (int i = 1; i < 16; ++i) G *= f[i];
    const int qb = lane & ~3;
    const float g0 = __shfl(G, qb), g1 = __shfl(G, qb + 1), g2 = __shfl(G, qb + 2), g3 = __shfl(G, qb + 3);
    const float dlast = (g0 * g1) * (g2 * g3);
    unsigned kew[8], vw[8];
    if (PASSB) {
        const float pre = (tg > 0 ? g0 : 1.f) * (tg > 1 ? g1 : 1.f) * (tg > 2 ? g2 : 1.f);
        float D = pre; float ke[16];
#pragma unroll
        for (int i = 0; i < 16; ++i) { D *= f[i]; const float rD = __builtin_amdgcn_rcpf(D);
            const float qp = bf2f(zp[(size_t)i * DIN + ZC_QH]); const float qd = silu_f(qp) * D; const float kd = (1.f - f[i]) * rD; ke[i] = kd * dlast;
            const int t = 16 * tg + i;
            *(LAS unsigned short*)(lds + QD_OFF + t * QS + c * 2) = (unsigned short)f2bf(qd);
            *(LAS unsigned short*)(lds + KD_OFF + t * QS + c * 2) = (unsigned short)f2bf(kd); }
#pragma unroll
        for (int i = 0; i < 8; ++i) kew[i] = cvtpk(ke[2 * i], ke[2 * i + 1]);
    } else {
        const float post = (tg < 1 ? g1 : 1.f) * (tg < 2 ? g2 : 1.f) * (tg < 3 ? g3 : 1.f);
        float ke[16]; float Q = post;
#pragma unroll
        for (int i = 15; i >= 0; --i) { ke[i] = (1.f - f[i]) * Q; Q *= f[i]; }
#pragma unroll
        for (int i = 0; i < 8; ++i) kew[i] = cvtpk(ke[2 * i], ke[2 * i + 1]);
        dseg *= dlast;
    }
#pragma unroll
    for (int i = 0; i < 8; ++i) { const unsigned lo = zp[(size_t)(2 * i) * DIN + ZC_IH], hi = zp[(size_t)(2 * i + 1) * DIN + ZC_IH]; vw[i] = lo | (hi << 16); }
    LAS u32x4* kp = (LAS u32x4*)(lds + KET_OFF + c * TS + 32 * tg); kp[0] = (u32x4){kew[0], kew[1], kew[2], kew[3]}; kp[1] = (u32x4){kew[4], kew[5], kew[6], kew[7]};
    LAS u32x4* vp = (LAS u32x4*)(lds + VT_OFF + c * TS + 32 * tg);  vp[0] = (u32x4){vw[0], vw[1], vw[2], vw[3]};     vp[1] = (u32x4){vw[4], vw[5], vw[6], vw[7]};
    if (tg == 0) *(LAS float*)(lds + DL_OFF + c * 4) = dlast;
}

__device__ __forceinline__ void state_update(f32x16& S0, f32x16& S1, LAS unsigned char* lds, int vb, int dbp, int ql, int hh) {
#pragma unroll
    for (int g = 0; g < 4; ++g) { const f32x4 d0 = *(const LAS f32x4*)(lds + DL_OFF + (32 * dbp + 8 * g + 4 * hh) * 4), d1 = *(const LAS f32x4*)(lds + DL_OFF + (32 * (dbp + 1) + 8 * g + 4 * hh) * 4);
#pragma unroll
        for (int e = 0; e < 4; ++e) { S0[4 * g + e] *= d0[e]; S1[4 * g + e] *= d1[e]; } }
#pragma unroll
    for (int ks = 0; ks < 4; ++ks) { const bf16x8 bv = *(const LAS bf16x8*)(lds + VT_OFF + (32 * vb + ql) * TS + (16 * ks + 8 * hh) * 2);
        const bf16x8 a0 = *(const LAS bf16x8*)(lds + KET_OFF + (32 * dbp + ql) * TS + (16 * ks + 8 * hh) * 2), a1 = *(const LAS bf16x8*)(lds + KET_OFF + (32 * (dbp + 1) + ql) * TS + (16 * ks + 8 * hh) * 2);
        S0 = __builtin_amdgcn_mfma_f32_32x32x16_bf16(a0, bv, S0, 0, 0, 0); S1 = __builtin_amdgcn_mfma_f32_32x32x16_bf16(a1, bv, S1, 0, 0, 0); }
}

__device__ __forceinline__ void passA_unit(const bf16* Z, float* Sloc, float* Dseg, const float* lb_logits, int unit, LAS unsigned char* lds, int tid, int lane, int wave) {
    const int s = unit & 7, bh = unit >> 3, h = bh & 7, b = bh >> 3;
    const int ql = lane & 31, hh = lane >> 5, vb = wave >> 1, dbp = (wave & 1) * 2;
    const int chn = h * 128 + (tid >> 2);
    const float lbd = 1.f / (1.f + __expf(lb_logits[1024 + chn] - lb_logits[chn]));
    f32x16 S0 = HG_ZERO16, S1 = HG_ZERO16; float dseg = 1.f;
    for (int ch = 0; ch < CHUNKS; ++ch) {
        const bf16* zc = Z + ((size_t)b * SEQ + s * SEG_TOK + ch * 64) * DIN + h * 128;
        elementwise<false>(zc, lds, tid, lane, lbd, dseg);
        __syncthreads();
        state_update(S0, S1, lds, vb, dbp, ql, hh);
        __syncthreads();
    }
    float* sl = Sloc + ((size_t)unit * 8 + wave) * 2048;
#pragma unroll
    for (int r = 0; r < 16; ++r) { sl[r * 64 + lane] = S0[r]; sl[(16 + r) * 64 + lane] = S1[r]; }
    if ((tid & 3) == 0) Dseg[(size_t)unit * 128 + (tid >> 2)] = dseg;
}

__device__ __forceinline__ void store_state_bf16(const f32x16& S0, const f32x16& S1, LAS unsigned char* lds, int vb, int dbp, int ql, int hh) {
#pragma unroll
    for (int g = 0; g < 4; ++g) {
        u32x2 w0; w0.x = cvtpk(S0[4*g+0], S0[4*g+1]); w0.y = cvtpk(S0[4*g+2], S0[4*g+3]);
        u32x2 w1; w1.x = cvtpk(S1[4*g+0], S1[4*g+1]); w1.y = cvtpk(S1[4*g+2], S1[4*g+3]);
        *(LAS u32x2*)(lds + ST_OFF + (32 * vb + ql) * QS + (32 * dbp + 8 * g + 4 * hh) * 2) = w0;
        *(LAS u32x2*)(lds + ST_OFF + (32 * vb + ql) * QS + (32 * (dbp + 1) + 8 * g + 4 * hh) * 2) = w1; }
}

__device__ __forceinline__ void passB_unit(const bf16* Z, bf16* Y, const float* Sloc, const float* Dseg, const float* lb_logits, const float* gnorm, int unit, LAS unsigned char* lds, int tid, int lane, int wave) {
    const int s = unit & 7, bh = unit >> 3, h = bh & 7, b = bh >> 3;
    const int ql = lane & 31, hh = lane >> 5, vb = wave >> 1, dbp = (wave & 1) * 2, cb = wave & 1;
    const int chn = h * 128 + (tid >> 2);
    const float lbd = 1.f / (1.f + __expf(lb_logits[1024 + chn] - lb_logits[chn]));
    f32x16 S0 = HG_ZERO16, S1 = HG_ZERO16; float dummy = 1.f;
    for (int sp = 0; sp < s; ++sp) {
        const float* sl = Sloc + ((size_t)(bh * 8 + sp) * 8 + wave) * 2048; const float* dg = Dseg + (size_t)(bh * 8 + sp) * 128;
#pragma unroll
        for (int r = 0; r < 16; ++r) { const int dd = (r & 3) + 8 * (r >> 2) + 4 * hh;
            S0[r] = S0[r] * dg[32 * dbp + dd] + sl[r * 64 + lane]; S1[r] = S1[r] * dg[32 * (dbp + 1) + dd] + sl[(16 + r) * 64 + lane]; }
    }
    store_state_bf16(S0, S1, lds, vb, dbp, ql, hh);
    for (int ch = 0; ch < CHUNKS; ++ch) {
        const size_t row0 = (size_t)b * SEQ + s * SEG_TOK + ch * 64;
        elementwise<true>(Z + row0 * DIN + h * 128, lds, tid, lane, lbd, dummy);
        __syncthreads();
        f32x16 O = HG_ZERO16;
#pragma unroll
        for (int ks = 0; ks < 8; ++ks) { const bf16x8 a = *(const LAS bf16x8*)(lds + ST_OFF + (32 * vb + ql) * QS + (16 * ks + 8 * hh) * 2), bq = *(const LAS bf16x8*)(lds + QD_OFF + (32 * cb + ql) * QS + (16 * ks + 8 * hh) * 2);
            O = __builtin_amdgcn_mfma_f32_32x32x16_bf16(a, bq, O, 0, 0, 0); }
        state_update(S0, S1, lds, vb, dbp, ql, hh);
        if (wave < 3) {
            const int sb = (wave == 2) ? 1 : 0, cb2 = (wave == 0) ? 0 : 1;
            f32x16 A = HG_ZERO16;
#pragma unroll
            for (int ks = 0; ks < 8; ++ks) { const bf16x8 a = *(const LAS bf16x8*)(lds + KD_OFF + (32 * sb + ql) * QS + (16 * ks + 8 * hh) * 2), bq = *(const LAS bf16x8*)(lds + QD_OFF + (32 * cb2 + ql) * QS + (16 * ks + 8 * hh) * 2);
                A = __builtin_amdgcn_mfma_f32_32x32x16_bf16(a, bq, A, 0, 0, 0); }
            if (sb == cb2) {
#pragma unroll
                for (int r = 0; r < 16; ++r) if ((r & 3) + 8 * (r >> 2) + 4 * hh > ql) A[r] = 0.f;
            }
#pragma unroll
            for (int g = 0; g < 4; ++g) { u32x2 w; w.x = cvtpk(A[4*g+0], A[4*g+1]); w.y = cvtpk(A[4*g+2], A[4*g+3]);
                *(LAS u32x2*)(lds + AM_OFF + (32 * cb2 + ql) * TS + (32 * sb + 8 * g + 4 * hh) * 2) = w; }
        }
        __syncthreads();
        store_state_bf16(S0, S1, lds, vb, dbp, ql, hh);
        if (cb) {
#pragma unroll
            for (int ks = 0; ks < 4; ++ks) { const bf16x8 a = *(const LAS bf16x8*)(lds + VT_OFF + (32 * vb + ql) * TS + (16 * ks + 8 * hh) * 2), bq = *(const LAS bf16x8*)(lds + AM_OFF + (32 + ql) * TS + (16 * ks + 8 * hh) * 2);
                O = __builtin_amdgcn_mfma_f32_32x32x16_bf16(a, bq, O, 0, 0, 0); }
        } else {
#pragma unroll
            for (int ks = 0; ks < 2; ++ks) { const bf16x8 a = *(const LAS bf16x8*)(lds + VT_OFF + (32 * vb + ql) * TS + (16 * ks + 8 * hh) * 2), bq = *(const LAS bf16x8*)(lds + AM_OFF + ql * TS + (16 * ks + 8 * hh) * 2);
                O = __builtin_amdgcn_mfma_f32_32x32x16_bf16(a, bq, O, 0, 0, 0); }
        }
        float ssq = 0.f;
#pragma unroll
        for (int r = 0; r < 16; ++r) ssq += O[r] * O[r];
        ssq += __shfl_xor(ssq, 32);
        if (hh == 0) *(LAS float*)(lds + SS_OFF + (vb * 64 + 32 * cb + ql) * 4) = ssq;
        __syncthreads();
        const int cc = 32 * cb + ql;
        const float tot = (*(const LAS float*)(lds + SS_OFF + cc * 4) + *(const LAS float*)(lds + SS_OFF + (64 + cc) * 4)) + (*(const LAS float*)(lds + SS_OFF + (128 + cc) * 4) + *(const LAS float*)(lds + SS_OFF + (192 + cc) * 4));
        const float rstd = 1.f / sqrtf(tot * (1.f / 128.f) + NORM_EPS);
        const bf16* grow = Z + (row0 + cc) * DIN + ZC_GH + h * 128; bf16* yrow = Y + (row0 + cc) * DM + h * 128;
#pragma unroll
        for (int g = 0; g < 4; ++g) { const int v0 = 32 * vb + 8 * g + 4 * hh;
            const uint2 gw = *(const uint2*)(grow + v0); const float4 gn = *(const float4*)(gnorm + v0);
            uint2 w; w.x = cvtpk(O[4*g+0] * rstd * gn.x * silu_f(bflo(gw.x)), O[4*g+1] * rstd * gn.y * silu_f(bfhi(gw.x)));
            w.y = cvtpk(O[4*g+2] * rstd * gn.z * silu_f(bflo(gw.y)), O[4*g+3] * rstd * gn.w * silu_f(bfhi(gw.y)));
            *(uint2*)(yrow + v0) = w; }
    }
    __syncthreads();
}
}
struct Args { const float* x; const float* norm_gain; const float* w_in; const float* lb_logits; const float* hgrn_gnorm; const float* w_out; const float* final_gain; float* out; unsigned char* ws; };
__global__ void __launch_bounds__(NWAVES * 64, 2) fwd_kernel(Args a) {
    __shared__ __attribute__((aligned(16))) unsigned char lds_raw[LDS_BYTES];
    LAS unsigned char* lds = (LAS unsigned char*)lds_raw;
    volatile LAS unsigned* MISC = (volatile LAS unsigned*)(lds + MISC_OFF);
    const int tid = threadIdx.x, lane = tid & 63, wave = __builtin_amdgcn_readfirstlane(tid >> 6);
    const int G = gridDim.x; const int bx = blockIdx.x; const int vcu = (G % 8 == 0) ? (bx % 8) * (G / 8) + bx / 8 : bx;
    unsigned char* ws = a.ws;
    gu32* ctl = (gu32*)(ws + WS_CTL);
    bf16* WIN_T = (bf16*)(ws + WS_WIN); bf16* WOUT_T = (bf16*)(ws + WS_WOUT); bf16* XN = (bf16*)(ws + WS_XN); bf16* Y = (bf16*)(ws + WS_Y); bf16* Z = (bf16*)(ws + WS_Z); float* SLOC = (float*)(ws + WS_SLOC); float* DSEG = (float*)(ws + WS_DSEG);
    for (int u = tid; u < (LDS_BYTES - LDSCTL_OFF) / 4; u += NWAVES * 64) ((LAS unsigned*)(lds + LDSCTL_OFF))[u] = 0u;
    __syncthreads();
    XcdBarrier bar = xcd_barrier_post((unsigned*)(ctl + CW_BAR), MISC + 8);
    const int gw = vcu * NWAVES + wave, NGW = G * NWAVES;

    {
        LAS float* scr = (LAS float*)(lds + RING_OFF + wave * 16384);
        constexpr int I_IN = (DM / 64) * (DIN / 32), I_OUT = (DM / 64) * (DM / 32);
        for (int it = gw; it < I_IN + I_OUT; it += NGW) {
            if (it < I_IN) p0_transpose_item(a.w_in, DM, DIN, WIN_T, scr, it, lane);
            else p0_transpose_item(a.w_out, DM, DM, WOUT_T, scr, it - I_IN, lane);
        }
        for (int m = gw; m < M; m += NGW) rms_row_to_bf16(a.x + (size_t)m * DM, a.norm_gain, XN + (size_t)m * DM, lane);
    }
    xcd_barrier(bar);
    {
        pg8::Gemm g{XN, WIN_T, M, DIN, DM}; pg8::StaticOrder S; S.init(M, DIN, G, bx);
        pg8::EpiBf16 E{Z, DIN};
        pg8::gemm_phase<pg8::EpiBf16, pg8::StaticOrder, true, true>(lds + RING_OFF, g, S, E);
    }
    xcd_barrier(bar);
    {
        if ((vcu & 7) != 7 && vcu < 256) hg::passA_unit(Z, SLOC, DSEG, a.lb_logits, vcu, lds + RING_OFF, tid, lane, wave);
        for (int it = vcu; it < BATCH * AT_HEADS * 16; it += G) att::unit(Z, Y, it, lds + RING_OFF, tid, lane, wave);
    }
    xcd_barrier(bar);
    for (int u = vcu; u < 256; u += G) hg::passB_unit(Z, Y, SLOC, DSEG, a.lb_logits, a.hgrn_gnorm, u, lds + RING_OFF, tid, lane, wave);
    xcd_barrier(bar);
    {
        pg8::Gemm g{Y, WOUT_T, M, DM, DM}; pg8::StaticOrder S; S.init(M, DM, G, bx);
        pg8::EpiResF32 E{a.x, a.out, DM};
        pg8::gemm_phase<pg8::EpiResF32, pg8::StaticOrder, true, true>(lds + RING_OFF, g, S, E);
    }
    xcd_barrier(bar);
    for (int m = gw; m < M; m += NGW) rms_row_inplace(a.out + (size_t)m * DM, a.final_gain, lane);
}

extern "C" void kernel_launch(void* const* d_in, const int* in_sizes, int n_in, void* d_out, int out_size, void* d_ws, size_t ws_size, hipStream_t stream) {
    static int grid = 0;
    if (grid == 0) {
        if (n_in != 7 || in_sizes[0] != M * DM || out_size != M * DM || ws_size < WS_END) { fprintf(stderr, "kernel_launch: unexpected shapes (n_in %d in0 %d out %d ws %zu)\n", n_in, n_in > 0 ? in_sizes[0] : -1, out_size, ws_size); grid = -1; return; }
        int dev = 0, cus = 0;
        if (hipGetDevice(&dev) != hipSuccess || hipDeviceGetAttribute(&cus, hipDeviceAttributeMultiprocessorCount, dev) != hipSuccess) { grid = -1; return; }
        grid = cus;
    }
    if (grid < 0) return;
    (void)hipMemsetAsync((char*)d_ws + WS_CTL, 0, CTL_ZERO_BYTES, stream);
    Args a{};
    a.x = (const float*)d_in[0]; a.norm_gain = (const float*)d_in[1]; a.w_in = (const float*)d_in[2]; a.lb_logits = (const float*)d_in[3];
    a.hgrn_gnorm = (const float*)d_in[4]; a.w_out = (const float*)d_in[5]; a.final_gain = (const float*)d_in[6];
    a.out = (float*)d_out; a.ws = (unsigned char*)d_ws;
    hipLaunchKernelGGL(fwd_kernel, dim3(grid), dim3(NWAVES * 64), 0, stream, a);
}
```

```cpp
#include <hip/hip_runtime.h>
#include <cstdio>
#include <cstdint>
namespace pg8 {
#define PG8_LAS __attribute__((address_space(3)))
typedef unsigned short bf16_t;
typedef short bf16x8 __attribute__((ext_vector_type(8)));
typedef float f32x4 __attribute__((ext_vector_type(4)));
typedef unsigned u32x4 __attribute__((ext_vector_type(4)));
constexpr int BM = 256, BK = 64, HALF = 128, HTB = HALF * BK * 2  , STAGE_BYTES = 8 * HTB, NXCD = 8, WGM = 8;

__host__ __device__ __forceinline__ int lds_byte(int r, int c) { const int st = (r >> 4) * 2 + (c >> 5), rr = r & 15, cc = c & 31, ob = rr * 64 + cc * 2; return st * 1024 + (ob ^ (((ob >> 9) & 1) << 5)); }
__host__ __device__ __forceinline__ void stage_rc(int b, int& R, int& C) { const int st = b / 1024, sb = b % 1024, swz = sb ^ (((sb >> 9) & 1) << 5); R = (st >> 1) * 16 + swz / 64; C = (st & 1) * 32 + (swz % 64) / 2; }
__host__ __device__ __forceinline__ int perm32(int rho) { const int n = rho >> 4, i = rho & 15; return 8 * (i >> 2) + 4 * n + (i & 3); }

struct Unit { int pm, pn; };
struct Gemm { const bf16_t* A; const bf16_t* Bt; int M, N, K; };

struct StaticOrder {
    int nM, nN, nwg, G, c;
    __host__ __device__ void init(int M, int N, int G_, int c_) { nM = M / BM; nN = N / BM; nwg = nM * nN; G = G_; c = c_; }
    __host__ __device__ bool next(int i, Unit& u) const {
        const long L = (long)i * G + c; if (L >= nwg) return false;
        int wgid = (int)L; { const int q = nwg / NXCD, r = nwg % NXCD, xcd = wgid % NXCD, off = wgid / NXCD; wgid = (xcd < r ? xcd * (q + 1) : r * (q + 1) + (xcd - r) * q) + off; }
        const int nig = WGM * nN, gid = wgid / nig, fm = gid * WGM, gsz = (nM - fm) < WGM ? (nM - fm) : WGM;
        u.pm = fm + ((wgid % nig) % gsz); u.pn = (wgid % nig) / gsz; return true;
    }
    __device__ __forceinline__ void a_ready(const Unit&) const {}
    __device__ __forceinline__ void done(const Unit&) const {}
};

__device__ __forceinline__ unsigned cvt_pk_bf16(float lo, float hi) { unsigned r; asm volatile("v_cvt_pk_bf16_f32 %0, %1, %2" : "=v"(r) : "v"(lo), "v"(hi)); return r; }
typedef float f32x2 __attribute__((ext_vector_type(2)));
struct EpiBf16 {
    static constexpr bool PERM = true, AFTER_DRAIN = false;
    bf16_t* O; int ldc;
    __device__ __forceinline__ void operator()(const f32x4 (&acc)[2][2][4][2], const Unit& u, int wr, int wc, int fr, int fq) const {
        const int row0 = u.pm * BM + wr * 64 + fr; const int col0 = u.pn * BM + wc * 32 + 8 * fq;
#pragma unroll
        for (int ai = 0; ai < 2; ++ai)
#pragma unroll
            for (int m = 0; m < 4; ++m) { bf16_t* rowp = O + (size_t)(row0 + ai * HALF + m * 16) * ldc + col0;
#pragma unroll
                for (int bj = 0; bj < 2; ++bj) { const f32x4 v0 = acc[ai][bj][m][0], v1 = acc[ai][bj][m][1];
                    u32x4 w; w.x = cvt_pk_bf16(v0[0], v0[1]); w.y = cvt_pk_bf16(v0[2], v0[3]); w.z = cvt_pk_bf16(v1[0], v1[1]); w.w = cvt_pk_bf16(v1[2], v1[3]);
                    *(u32x4*)(rowp + bj * HALF) = w; } }
    }
};
struct EpiResF32 {
    static constexpr bool PERM = false, AFTER_DRAIN = false;
    const float* base; float* C; int ldc;
    __device__ __forceinline__ void operator()(const f32x4 (&acc)[2][2][4][2], const Unit& u, int wr, int wc, int fr, int fq) const {
        const int row0 = u.pm * BM + wr * 64 + fr, col0 = u.pn * BM + wc * 32 + 4 * fq;
#pragma unroll
        for (int ai = 0; ai < 2; ++ai)
#pragma unroll
            for (int m = 0; m < 4; ++m) { const size_t off = (size_t)(row0 + ai * HALF + m * 16) * ldc + col0;
#pragma unroll
                for (int bj = 0; bj < 2; ++bj)
#pragma unroll
                    for (int n = 0; n < 2; ++n) *(f32x4*)(C + off + bj * HALF + n * 16) = *(const f32x4*)(base + off + bj * HALF + n * 16) + acc[ai][bj][m][n]; }
    }
};
template <class Epi, class Sched, bool ALIGN_EPI = false, bool SP2 = false>
__device__ __forceinline__ void gemm_phase(PG8_LAS unsigned char* lds, const Gemm g, const Sched& S, const Epi& E) {
    const int tid = threadIdx.x, wid = __builtin_amdgcn_readfirstlane(tid >> 6), lane = tid & 63, wr = wid >> 2, wc = wid & 3, fr = lane & 15, fq = lane >> 4;
    const int K = g.K, nt = K / BK;
    unsigned voffA[2], voffB[2];
#pragma unroll
    for (int i = 0; i < 2; ++i) { int R, C; stage_rc(tid * 16 + i * 8192, R, C); const int Rb = Epi::PERM ? ((R & ~31) + perm32(R & 31)) : R;
        voffA[i] = (unsigned)(R * K + C) * 2u; voffB[i] = (unsigned)(Rb * K + C) * 2u; }
    const size_t kstep = (size_t)(BK * 2);
    const size_t hstep = (size_t)HALF * K * 2;
    const size_t tstep = 2 * hstep;
    const unsigned ldsw = (unsigned)wid * 1024u;
    const int aoff = lds_byte(wr * 64 + fr, fq * 8), boff = lds_byte(wc * 32 + fr, fq * 8);
#define PG8_SA(b, h) (((b) * 2 + (h)) * HTB)
#define PG8_SB(b, h) ((4 + (b) * 2 + (h)) * HTB)
#define PG8_STAGE(bufoff, gbase, voff) do { _Pragma("unroll") for (int _i = 0; _i < 2; ++_i) \
        __builtin_amdgcn_global_load_lds((const unsigned*)((const char*)(gbase) + (voff)[_i]), (PG8_LAS unsigned*)(lds + (bufoff) + ldsw + _i * 8192), 16, 0, 0); } while (0)
#define PG8_LDA(dst, b, h) do { _Pragma("unroll") for (int m = 0; m < 4; ++m) _Pragma("unroll") for (int k = 0; k < 2; ++k) dst[m][k] = *(const PG8_LAS bf16x8*)(lds + PG8_SA(b, h) + aoff + m * 2048 + k * 1024); } while (0)
#define PG8_LDB(dst, b, h) do { _Pragma("unroll") for (int n = 0; n < 2; ++n) _Pragma("unroll") for (int k = 0; k < 2; ++k) dst[n][k] = *(const PG8_LAS bf16x8*)(lds + PG8_SB(b, h) + boff + n * 2048 + k * 1024); } while (0)
#define PG8_MMA(ai, bj, At, Bt) do { __builtin_amdgcn_s_setprio(1); _Pragma("unroll") for (int m = 0; m < 4; ++m) _Pragma("unroll") for (int n = 0; n < 2; ++n) _Pragma("unroll") for (int k = 0; k < 2; ++k) \
        acc[ai][bj][m][n] = __builtin_amdgcn_mfma_f32_16x16x32_bf16(Bt[n][k], At[m][k], acc[ai][bj][m][n], 0, 0, 0); __builtin_amdgcn_s_setprio(0); } while (0)
#define PG8_WAIT_V(n) asm volatile("s_waitcnt vmcnt(" #n ")" ::: "memory")
#define PG8_WAIT_L(n) asm volatile("s_waitcnt lgkmcnt(" #n ")" ::: "memory")
#define PG8_BAR __builtin_amdgcn_s_barrier()
#define PG8_SCHED __builtin_amdgcn_sched_barrier(0)
    Unit cur, nxt; int ui = 0;
    if (!S.next(0, cur)) return;
    f32x4 acc[2][2][4][2];
#pragma unroll
    for (int a = 0; a < 2; ++a)
#pragma unroll
        for (int b = 0; b < 2; ++b)
#pragma unroll
            for (int m = 0; m < 4; ++m)
#pragma unroll
                for (int n = 0; n < 2; ++n) acc[a][b][m][n] = (f32x4){0.f, 0.f, 0.f, 0.f};
    bf16x8 At[4][2], B0[2][2], B1[2][2];
    const char* cA = (const char*)g.A + (size_t)cur.pm * tstep; const char* cB = (const char*)g.Bt + (size_t)cur.pn * tstep;
    S.a_ready(cur);
    if constexpr (SP2) {
        PG8_STAGE(PG8_SB(0, 0), cB, voffB); PG8_STAGE(PG8_SB(0, 1), cB + hstep, voffB); PG8_STAGE(PG8_SA(0, 0), cA, voffA); PG8_STAGE(PG8_SA(0, 1), cA + hstep, voffA);
        if (wr == 1) PG8_BAR;
        PG8_WAIT_V(2); PG8_BAR;
        PG8_STAGE(PG8_SB(1, 0), cB + kstep, voffB); PG8_STAGE(PG8_SA(1, 0), cA + kstep, voffA); PG8_STAGE(PG8_SB(1, 1), cB + hstep + kstep, voffB);
        PG8_WAIT_V(6); PG8_BAR;
    } else {
        PG8_STAGE(PG8_SB(0, 0), cB, voffB); PG8_STAGE(PG8_SA(0, 0), cA, voffA); PG8_STAGE(PG8_SB(0, 1), cB + hstep, voffB); PG8_STAGE(PG8_SA(0, 1), cA + hstep, voffA);
        if (wr == 1) PG8_BAR;
        PG8_WAIT_V(4); PG8_BAR;
        PG8_STAGE(PG8_SB(1, 0), cB + kstep, voffB); PG8_STAGE(PG8_SA(1, 0), cA + kstep, voffA); PG8_STAGE(PG8_SB(1, 1), cB + hstep + kstep, voffB);
        PG8_WAIT_V(6); PG8_BAR;
    }
    for (;;) {
        const bool has_next = S.next(ui + 1, nxt);
        const char* nA = has_next ? (const char*)g.A + (size_t)nxt.pm * tstep : cA; const char* nB = has_next ? (const char*)g.Bt + (size_t)nxt.pn * tstep : cB;
        for (int t = 0; t < nt; t += 2) {
            const bool last = (t == nt - 2);
            const char* a1 = cA + (size_t)(t + 1) * kstep;
            const char* a2 = last ? nA : cA + (size_t)(t + 2) * kstep; const char* b2 = last ? nB : cB + (size_t)(t + 2) * kstep;
            const char* a3 = a2 + kstep; const char* b3 = b2 + kstep;
            if (last && has_next) S.a_ready(nxt);
            if constexpr (SP2) {
            PG8_LDB(B0, 0, 0); PG8_LDB(B1, 0, 1); PG8_SCHED; PG8_LDA(At, 0, 0); PG8_STAGE(PG8_SA(1, 1), a1 + hstep, voffA);
            PG8_WAIT_V(8); PG8_WAIT_L(0); PG8_BAR; PG8_MMA(0, 0, At, B0); PG8_MMA(0, 1, At, B1); PG8_BAR; PG8_SCHED;
            PG8_LDA(At, 0, 1); PG8_STAGE(PG8_SB(0, 0), b2, voffB); PG8_STAGE(PG8_SB(0, 1), b2 + hstep, voffB); PG8_STAGE(PG8_SA(0, 0), a2, voffA);
            PG8_WAIT_V(8); PG8_WAIT_L(0); PG8_BAR; PG8_MMA(1, 0, At, B0); PG8_MMA(1, 1, At, B1); PG8_BAR; PG8_SCHED;
            PG8_LDB(B0, 1, 0); PG8_LDB(B1, 1, 1); PG8_SCHED; PG8_LDA(At, 1, 0); PG8_STAGE(PG8_SA(0, 1), a2 + hstep, voffA);
            PG8_WAIT_V(8); PG8_WAIT_L(0); PG8_BAR; PG8_MMA(0, 0, At, B0); PG8_MMA(0, 1, At, B1); PG8_BAR; PG8_SCHED;
            PG8_LDA(At, 1, 1); PG8_STAGE(PG8_SB(1, 0), b3, voffB); PG8_STAGE(PG8_SB(1, 1), b3 + hstep, voffB); PG8_STAGE(PG8_SA(1, 0), a3, voffA);
            PG8_WAIT_V(8); PG8_WAIT_L(0); PG8_BAR; PG8_MMA(1, 0, At, B0); PG8_MMA(1, 1, At, B1); PG8_BAR; PG8_SCHED;
            } else {
            PG8_LDB(B0, 0, 0); PG8_SCHED; PG8_LDA(At, 0, 0); PG8_STAGE(PG8_SA(1, 1), a1 + hstep, voffA);
            PG8_WAIT_L(8); PG8_BAR; PG8_WAIT_L(0); PG8_MMA(0, 0, At, B0); PG8_BAR; PG8_SCHED;
            PG8_LDB(B1, 0, 1); PG8_STAGE(PG8_SB(0, 0), b2, voffB);
            PG8_BAR; PG8_WAIT_L(0); PG8_MMA(0, 1, At, B1); PG8_BAR;
            PG8_LDA(At, 0, 1); PG8_STAGE(PG8_SA(0, 0), a2, voffA);
            PG8_BAR; PG8_WAIT_L(0); PG8_MMA(1, 0, At, B0); PG8_BAR; PG8_SCHED;
            PG8_STAGE(PG8_SB(0, 1), b2 + hstep, voffB);
            PG8_WAIT_V(6); PG8_BAR; PG8_MMA(1, 1, At, B1); PG8_BAR;
            PG8_LDB(B0, 1, 0); PG8_SCHED; PG8_LDA(At, 1, 0); PG8_STAGE(PG8_SA(0, 1), a2 + hstep, voffA);
            PG8_WAIT_L(8); PG8_BAR; PG8_WAIT_L(0); PG8_MMA(0, 0, At, B0); PG8_BAR; PG8_SCHED;
            PG8_LDB(B1, 1, 1); PG8_STAGE(PG8_SB(1, 0), b3, voffB);
            PG8_BAR; PG8_WAIT_L(0); PG8_MMA(0, 1, At, B1); PG8_BAR;
            PG8_LDA(At, 1, 1); PG8_STAGE(PG8_SA(1, 0), a3, voffA);
            PG8_BAR; PG8_WAIT_L(0); PG8_MMA(1, 0, At, B0); PG8_BAR; PG8_SCHED;
            PG8_STAGE(PG8_SB(1, 1), b3 + hstep, voffB);
            PG8_WAIT_V(6); PG8_BAR; PG8_MMA(1, 1, At, B1); PG8_BAR;
            }
        }
        if constexpr (ALIGN_EPI) { if (wr == 0) PG8_BAR; }
        if constexpr (!Epi::AFTER_DRAIN) { E(acc, cur, wr, wc, fr, fq); S.done(cur); }
        if (!has_next) break;
#pragma unroll
        for (int a = 0; a < 2; ++a)
#pragma unroll
            for (int b = 0; b < 2; ++b)
#pragma unroll
                for (int m = 0; m < 4; ++m)
#pragma unroll
                    for (int n = 0; n < 2; ++n) acc[a][b][m][n] = (f32x4){0.f, 0.f, 0.f, 0.f};
        cur = nxt; cA = nA; cB = nB; ++ui;
        if constexpr (ALIGN_EPI) { if (wr == 1) PG8_BAR; }
    }
    PG8_WAIT_V(0);
    if constexpr (!ALIGN_EPI) { if (wr == 0) PG8_BAR; }
    PG8_BAR;
    if constexpr (Epi::AFTER_DRAIN) { E.fused(acc, cur, wr, wc, fr, fq, lds, wid, lane); S.done(cur); }
#undef PG8_SA
#undef PG8_SB
#undef PG8_STAGE
#undef PG8_LDA
#undef PG8_LDB
#undef PG8_MMA
#undef PG8_WAIT_V
#undef PG8_WAIT_L
#undef PG8_BAR
#undef PG8_SCHED
}
}
#define GAS __attribute__((address_space(1)))
#define LAS __attribute__((address_space(3)))
typedef unsigned short bf16;
typedef unsigned v4u __attribute__((ext_vector_type(4)));
typedef float f32x4 __attribute__((ext_vector_type(4)));
typedef short bf16x8 __attribute__((ext_vector_type(8)));
typedef GAS unsigned gu32;
typedef GAS unsigned long long gu64;
#define RLX_AGENT __ATOMIC_RELAXED, __HIP_MEMORY_SCOPE_AGENT
#define LDS_WAIT() asm volatile("s_waitcnt lgkmcnt(0)" ::: "memory")
#define VM_WAIT() asm volatile("s_waitcnt vmcnt(0)" ::: "memory")
__device__ __forceinline__ unsigned long long rt() { return __builtin_amdgcn_s_memrealtime(); }
__device__ __forceinline__ unsigned f2bf(float f) { unsigned u = __builtin_bit_cast(unsigned, f); return (u + 0x7fffu + ((u >> 16) & 1u)) >> 16; }
__device__ __forceinline__ unsigned pk2(float lo, float hi) { return f2bf(lo) | (f2bf(hi) << 16); }
#define XB_TMO      128
#define XB_XCNT(j)  (256  + 64 * (j))
#define XB_XSUB(j)  (1280 + 64 * (j))
#define XB_XGEN(j)  (2304 + 64 * (j))
#define XB_TOP      3328
#define XB_TOPGEN   3392
#define XCD_BAR_WORDS 3456
#define XB_SPIN_CAP (1u << 18)

__device__ __forceinline__ unsigned xb_ld(unsigned* p)              { return __hip_atomic_load(p, __ATOMIC_RELAXED, __HIP_MEMORY_SCOPE_AGENT); }
__device__ __forceinline__ unsigned xb_add(unsigned* p, unsigned v) { return __hip_atomic_fetch_add(p, v, __ATOMIC_RELAXED, __HIP_MEMORY_SCOPE_AGENT); }
__device__ __forceinline__ unsigned xb_xcc_id() { return (unsigned)__builtin_amdgcn_s_getreg((3 << 11) | 20) & 0xFu; }
#define XB_SPIN(cond, bar) do { unsigned _sp = 0; while (cond) { __builtin_amdgcn_s_sleep(1); \
    if ((++_sp & 255u) == 0u) { if (xb_ld(&(bar)[XB_TMO])) break; if (_sp > XB_SPIN_CAP) { atomicAdd(&(bar)[XB_TMO], 1u); break; } } } } while (0)

struct XcdBarrier {
    unsigned* bar; unsigned x;
    volatile LAS unsigned* st;
};

__device__ __forceinline__ XcdBarrier xcd_barrier_post(unsigned* bar, volatile LAS unsigned* st) {
    XcdBarrier b; b.bar = bar; b.x = xb_xcc_id(); b.st = st;
    if (threadIdx.x == 0) (void)xb_add(&bar[XB_XCNT(b.x)], 1u);
    return b;
}
__device__ __forceinline__ void xcd_barrier_complete(unsigned* bar, unsigned x, unsigned& nloc, unsigned& nx) {
    const unsigned G = gridDim.x * gridDim.y * gridDim.z;
    unsigned sum, cnt, mine, sp = 0u;
    for (;;) {
        sum = 0u; cnt = 0u; mine = 0u;
#pragma unroll
        for (unsigned j = 0; j < 16; ++j) { const unsigned c = xb_ld(&bar[XB_XCNT(j)]); sum += c; cnt += (c > 0u) ? 1u : 0u; mine = (j == x) ? c : mine; }
        if (sum == G) break;
        __builtin_amdgcn_s_sleep(1);
        if ((++sp & 255u) == 0u) { if (xb_ld(&bar[XB_TMO])) break; if (sp > XB_SPIN_CAP) { atomicAdd(&bar[XB_TMO], 1u); break; } }
    }
    nloc = mine > 0u ? mine : 1u; nx = cnt > 0u ? cnt : 1u;
}

__device__ __forceinline__ void xcd_barrier(const XcdBarrier& b) {
    asm volatile("s_waitcnt vmcnt(0)" ::: "memory");
    __syncthreads();
    if (threadIdx.x == 0) {
        unsigned* bar = b.bar;
        __builtin_amdgcn_s_waitcnt(0);
        unsigned nloc = b.st[0], nx = b.st[1];
        if (nloc == 0u) { xcd_barrier_complete(bar, b.x, nloc, nx); b.st[0] = nloc; b.st[1] = nx; }
        const unsigned old = xb_add(&bar[XB_XSUB(b.x)], 1u);
        const unsigned gen = old / nloc;
        if (old + 1u == (gen + 1u) * nloc) {
            __builtin_amdgcn_fence(__ATOMIC_RELEASE, "agent");
            asm volatile("s_waitcnt vmcnt(0)" ::: "memory");
            const unsigned og = xb_add(&bar[XB_TOP], 1u);
            const unsigned tg = og / nx;
            if (og + 1u == (tg + 1u) * nx) xb_add(&bar[XB_TOPGEN], 1u);
            else XB_SPIN(xb_ld(&bar[XB_TOPGEN]) == tg, bar);
            __builtin_amdgcn_fence(__ATOMIC_ACQUIRE, "agent");
            xb_add(&bar[XB_XGEN(b.x)], 1u);
            asm volatile("s_waitcnt vmcnt(0)" ::: "memory");
        } else {
            XB_SPIN(xb_ld(&bar[XB_XGEN(b.x)]) == gen, bar);
            __builtin_amdgcn_fence(__ATOMIC_ACQUIRE, "agent");
            asm volatile("s_waitcnt vmcnt(0)" ::: "memory");
        }
    }
    __syncthreads();
}
constexpr int NWAVES = 8;
constexpr int BATCH = 4, SEQ = 8192, DM = 2048, DIN = 8192, M = BATCH * SEQ;
constexpr int HG_HEADS = 8, HG_D = 128, AT_HEADS = 16, AT_D = 64;
constexpr int ZC_QH = 0, ZC_FH = 1024, ZC_IH = 2048, ZC_GH = 3072, ZC_QA = 4096, ZC_KA = 5120, ZC_VA = 6144, ZC_GA = 7168;
constexpr float NORM_EPS = 1e-6f;
constexpr size_t MiB = 1u << 20;
constexpr size_t WS_CTL = 0, CTL_ZERO_BYTES = 1 * MiB;
constexpr size_t WS_WIN = 2 * MiB;
constexpr size_t WS_WOUT = 34 * MiB;
constexpr size_t WS_SLOC = 42 * MiB;
constexpr size_t WS_DSEG = 58 * MiB;
constexpr size_t WS_XN = 64 * MiB;
constexpr size_t WS_Y = 192 * MiB;
constexpr size_t WS_Z = 320 * MiB;
constexpr size_t WS_END = 832 * MiB;
constexpr int CW_BAR = 4096;
constexpr int RING_OFF = 0, RING_BYTES = 131072;
constexpr int LDSCTL_OFF = 155648, MISC_OFF = LDSCTL_OFF + 320;
constexpr int LDS_BYTES = 163840;
__device__ __forceinline__ float wave_sum(float v) {
#pragma unroll
    for (int o = 1; o < 64; o <<= 1) v += __shfl_xor(v, o);
    return v;
}
__device__ __forceinline__ float bflo(unsigned w) { return __uint_as_float(w << 16); }
__device__ __forceinline__ float bfhi(unsigned w) { return __uint_as_float(w & 0xffff0000u); }
__device__ __forceinline__ float bf2f(bf16 v) { return __uint_as_float((unsigned)v << 16); }
__device__ __forceinline__ float silu_f(float x) { return x / (1.f + __expf(-x)); }
__device__ __forceinline__ float sigmoid_f(float x) { return 1.f / (1.f + __expf(-x)); }

__device__ __forceinline__ void p0_transpose_item(const float* W, int K, int N, bf16* WT, LAS float* scr, int item, int lane) {
    const int nblk = N / 32, kb = item / nblk, nb = item % nblk, k0 = 64 * kb, n0 = 32 * nb;
#pragma unroll 8
    for (int i = 0; i < 32; ++i) { const int kk = 2 * i + (lane >> 5); scr[kk * 33 + (lane & 31)] = W[(size_t)(k0 + kk) * N + n0 + (lane & 31)]; }
    LDS_WAIT(); asm volatile("" ::: "memory");
    const int c = lane & 7;
#pragma unroll
    for (int j = 0; j < 4; ++j) { const int n = (lane >> 3) + 8 * j; const LAS float* s = scr + (8 * c) * 33 + n;
        v4u o; o.x = pk2(s[0 * 33], s[1 * 33]); o.y = pk2(s[2 * 33], s[3 * 33]); o.z = pk2(s[4 * 33], s[5 * 33]); o.w = pk2(s[6 * 33], s[7 * 33]);
        *(GAS v4u*)(WT + (size_t)(n0 + n) * K + k0 + 8 * c) = o; }
    LDS_WAIT(); asm volatile("" ::: "memory");
}
__device__ __forceinline__ void rms_row_to_bf16(const float* xrow, const float* gain, bf16* orow, int lane) {
    const GAS f32x4* xr = (const GAS f32x4*)xrow + lane; const GAS f32x4* gr = (const GAS f32x4*)gain + lane;
    f32x4 v[8]; float s = 0.f;
#pragma unroll
    for (int j = 0; j < 8; ++j) { v[j] = xr[64 * j]; s += (v[j].x * v[j].x + v[j].y * v[j].y) + (v[j].z * v[j].z + v[j].w * v[j].w); }
    const float rstd = 1.f / sqrtf(wave_sum(s) * (1.f / DM) + NORM_EPS);
    GAS unsigned long long* o8 = (GAS unsigned long long*)orow + lane;
#pragma unroll
    for (int j = 0; j < 8; ++j) { const f32x4 g = gr[64 * j];
        o8[64 * j] = (unsigned long long)pk2(v[j].x * rstd * g.x, v[j].y * rstd * g.y) | ((unsigned long long)pk2(v[j].z * rstd * g.z, v[j].w * rstd * g.w) << 32); }
}
__device__ __forceinline__ void rms_row_inplace(float* row, const float* gain, int lane) {
    GAS f32x4* xr = (GAS f32x4*)row + lane; const GAS f32x4* gr = (const GAS f32x4*)gain + lane;
    f32x4 v[8]; float s = 0.f;
#pragma unroll
    for (int j = 0; j < 8; ++j) { v[j] = xr[64 * j]; s += (v[j].x * v[j].x + v[j].y * v[j].y) + (v[j].z * v[j].z + v[j].w * v[j].w); }
    const float rstd = 1.f / sqrtf(wave_sum(s) * (1.f / DM) + NORM_EPS);
#pragma unroll
    for (int j = 0; j < 8; ++j) { const f32x4 g = gr[64 * j]; xr[64 * j] = v[j] * rstd * g; }
}

namespace att {
typedef float f32x16 __attribute__((ext_vector_type(16)));
typedef short v4i16_t __attribute__((ext_vector_type(4)));
typedef unsigned u32x4 __attribute__((ext_vector_type(4)));
typedef unsigned u32x2 __attribute__((ext_vector_type(2)));
constexpr int KS = 144, VS = 192, WAVE_BYTES = 32 * KS + 32 * VS;
constexpr int OST_OFF = 8 * WAVE_BYTES, LSE_OFF = OST_OFF + 512 * 128, TOTAL_BYTES = LSE_OFF + 512 * 4;
constexpr float C1 = 0.125f * 1.4426950408889634f;
__device__ __forceinline__ int ost_byte(int tb, int c8) { return tb * 128 + ((((c8 >> 1) ^ (tb ^ (tb >> 4))) & 7) << 4) + ((c8 & 1) << 3); }
__device__ __forceinline__ unsigned cvtpk(float lo, float hi) { unsigned r; asm volatile("v_cvt_pk_bf16_f32 %0, %1, %2" : "=v"(r) : "v"(lo), "v"(hi)); return r; }

template <int DIL, bool FIRST>
__device__ __forceinline__ void tile(const bf16* zb, int h, int tq0, int tb0, int tbs, LAS unsigned char* Kt, LAS unsigned char* Vt, LAS unsigned char* Ost, LAS float* Lse, int lane, float sl2) {
    const int ql = lane & 31, hh = lane >> 5;
    const int u0 = tq0 / DIL;
    const int kt0 = (u0 >= 128) ? 0 : ((128 - u0) >> 5);
    bf16x8 qf[4];
    { const bf16* qp = zb + (size_t)(tq0 + DIL * ql) * DIN + ZC_QA + h * 64 + 8 * hh;
#pragma unroll
      for (int kk = 0; kk < 4; ++kk) qf[kk] = *(const bf16x8*)(qp + 16 * kk); }
    const int lrow = lane >> 3, lch = lane & 7;
    u32x4 kn[4], vn[4];
#define ATT_LOADKV(kt) do { _Pragma("unroll") for (int i_ = 0; i_ < 4; ++i_) { const bf16* rp_ = zb + (size_t)(tq0 + DIL * (32 * (kt) - 128 + 8 * i_ + lrow)) * DIN + h * 64 + lch * 8; \
        kn[i_] = *(const u32x4*)(rp_ + ZC_KA); vn[i_] = *(const u32x4*)(rp_ + ZC_VA); } } while (0)
#define ATT_STOREKV() do { _Pragma("unroll") for (int i_ = 0; i_ < 4; ++i_) { *(LAS u32x4*)(Kt + (8 * i_ + lrow) * KS + lch * 16) = kn[i_]; *(LAS u32x4*)(Vt + (8 * i_ + lrow) * VS + lch * 16) = vn[i_]; } } while (0)
    float m = -INFINITY, l = 0.f;
    f32x16 O0 = {0.f,0.f,0.f,0.f,0.f,0.f,0.f,0.f,0.f,0.f,0.f,0.f,0.f,0.f,0.f,0.f}, O1 = O0;
    const int li = lane & 15, vbase = (4 * hh + (li >> 2)) * VS + (16 * ((lane >> 4) & 1) + 4 * (li & 3)) * 2;
    ATT_LOADKV(kt0); ATT_STOREKV();
    asm volatile("" :: "v"(qf[0]), "v"(qf[1]), "v"(qf[2]), "v"(qf[3]));
#pragma unroll 1
    for (int kt = kt0; kt <= 4; ++kt) {
        if (kt < 4) ATT_LOADKV(kt + 1);
        f32x16 S = {0.f,0.f,0.f,0.f,0.f,0.f,0.f,0.f,0.f,0.f,0.f,0.f,0.f,0.f,0.f,0.f};
#pragma unroll
        for (int kk = 0; kk < 4; ++kk) { const bf16x8 kf = *(const LAS bf16x8*)(Kt + ql * KS + (16 * kk + 8 * hh) * 2); S = __builtin_amdgcn_mfma_f32_32x32x16_bf16(kf, qf[kk], S, 0, 0, 0); }
        bf16x8 vf[2][2];
#pragma unroll
        for (int s = 0; s < 2; ++s)
#pragma unroll
            for (int dh = 0; dh < 2; ++dh) {
                const v4i16_t a0 = __builtin_amdgcn_ds_read_tr16_b64_v4i16((LAS v4i16_t*)(Vt + vbase + (16 * s) * VS + dh * 64));
                const v4i16_t a1 = __builtin_amdgcn_ds_read_tr16_b64_v4i16((LAS v4i16_t*)(Vt + vbase + (16 * s + 8) * VS + dh * 64));
                vf[s][dh] = (bf16x8){a0[0], a0[1], a0[2], a0[3], a1[0], a1[1], a1[2], a1[3]}; }
        const float dbase = (float)(128 - 32 * kt + ql - 4 * hh);
        float sv[16];
#pragma unroll
        for (int r = 0; r < 16; ++r) { const float dl = dbase - (float)((r & 3) + 8 * (r >> 2)); const float v = __builtin_fmaf(-sl2, dl, S[r] * C1); sv[r] = (__builtin_fabsf(dl - 64.f) <= 64.f) ? v : -INFINITY; }
        float rm = sv[0];
#pragma unroll
        for (int r = 1; r < 16; ++r) rm = fmaxf(rm, sv[r]);
        rm = fmaxf(rm, __shfl_xor(rm, 32));
        const float mn = fmaxf(m, rm); const float alpha = __builtin_amdgcn_exp2f(m - mn); m = mn;
        float ps = 0.f;
#pragma unroll
        for (int r = 0; r < 16; ++r) { sv[r] = __builtin_amdgcn_exp2f(sv[r] - mn); ps += sv[r]; }
        l = l * alpha + ps;
        O0 *= alpha; O1 *= alpha;
        u32x4 pw[2];
#pragma unroll
        for (int s = 0; s < 2; ++s) { pw[s].x = cvtpk(sv[8*s+0], sv[8*s+1]); pw[s].y = cvtpk(sv[8*s+2], sv[8*s+3]); pw[s].z = cvtpk(sv[8*s+4], sv[8*s+5]); pw[s].w = cvtpk(sv[8*s+6], sv[8*s+7]); }
#pragma unroll
        for (int s = 0; s < 2; ++s) {
            const bf16x8 pf = __builtin_bit_cast(bf16x8, pw[s]);
            O0 = __builtin_amdgcn_mfma_f32_32x32x16_bf16(vf[s][0], pf, O0, 0, 0, 0); O1 = __builtin_amdgcn_mfma_f32_32x32x16_bf16(vf[s][1], pf, O1, 0, 0, 0);
        }
        asm volatile("" ::: "memory");
        if (kt < 4) ATT_STOREKV();
        asm volatile("" ::: "memory");
    }
#undef ATT_LOADKV
#undef ATT_STOREKV
    const float lt = l + __shfl_xor(l, 32);
    const float lse = m + __builtin_amdgcn_logf(lt);
    const int tb = tb0 + tbs * ql;
    if (FIRST) {
        const float sc = 1.f / lt;
#pragma unroll
        for (int dh = 0; dh < 2; ++dh)
#pragma unroll
            for (int g = 0; g < 4; ++g) { const f32x16& O = dh ? O1 : O0;
                u32x2 w; w.x = cvtpk(O[4*g+0] * sc, O[4*g+1] * sc); w.y = cvtpk(O[4*g+2] * sc, O[4*g+3] * sc);
                *(LAS u32x2*)(Ost + ost_byte(tb, 8 * dh + 2 * g + hh)) = w; }
        if (hh == 0) Lse[tb] = lse;
    } else {
        const float lp = Lse[tb]; const float M = fmaxf(lp, lse); const float wp = __builtin_amdgcn_exp2f(lp - M), wc = __builtin_amdgcn_exp2f(lse - M);
        const float inv = 1.f / (wp + wc); const float a = wp * inv, c = wc * inv / lt;
#pragma unroll
        for (int dh = 0; dh < 2; ++dh)
#pragma unroll
            for (int g = 0; g < 4; ++g) { const f32x16& O = dh ? O1 : O0; LAS u32x2* p = (LAS u32x2*)(Ost + ost_byte(tb, 8 * dh + 2 * g + hh));
                const u32x2 pv = *p; u32x2 w;
                w.x = cvtpk(bflo(pv.x) * a + O[4*g+0] * c, bfhi(pv.x) * a + O[4*g+1] * c); w.y = cvtpk(bflo(pv.y) * a + O[4*g+2] * c, bfhi(pv.y) * a + O[4*g+3] * c);
                *p = w; }
        asm volatile("" ::: "memory");
        if (hh == 0) Lse[tb] = M + __builtin_amdgcn_logf(wp + wc);
    }
}

__device__ __forceinline__ void unit(const bf16* Z, bf16* Y, int item, LAS unsigned char* lds, int tid, int lane, int wave) {
    const int blk = item & 15, h = (item >> 4) & 15, b = item >> 8, T0 = blk * 512;
    const bf16* zb = Z + (size_t)b * SEQ * DIN;
    LAS unsigned char* Kt = lds + wave * WAVE_BYTES; LAS unsigned char* Vt = Kt + 32 * KS;
    LAS unsigned char* Ost = lds + OST_OFF; LAS float* Lse = (LAS float*)(lds + LSE_OFF);
    const float slope2 = exp2f(-0.5f * (float)(h + 1)) * 1.4426950408889634f;
    for (int j = 0; j < 2; ++j) { const int i = wave + 8 * j; tile<16, true>(zb, h, T0 + i, i, 16, Kt, Vt, Ost, Lse, lane, slope2 * 16.f); }
    __syncthreads();
    for (int j = 0; j < 2; ++j) { const int i = wave + 8 * j, r4 = i >> 2, sb = i & 3; tile<4, false>(zb, h, T0 + 128 * sb + r4, 128 * sb + r4, 4, Kt, Vt, Ost, Lse, lane, slope2 * 4.f); }
    __syncthreads();
    for (int j = 0; j < 2; ++j) { const int i = wave + 8 * j; tile<1, false>(zb, h, T0 + 32 * i, 32 * i, 1, Kt, Vt, Ost, Lse, lane, slope2); }
    __syncthreads();
#pragma unroll
    for (int i = 0; i < 8; ++i) { const int idx = tid + 512 * i, tb = idx >> 3, c16 = idx & 7;
        const u32x4 o = *(const LAS u32x4*)(Ost + ost_byte(tb, 2 * c16));
        const size_t row = (size_t)b * SEQ + T0 + tb;
        const uint4 g = *(const uint4*)(Z + row * DIN + ZC_GA + h * 64 + c16 * 8);
        uint4 w;
        w.x = pk2(bflo(o.x) * silu_f(bflo(g.x)), bfhi(o.x) * silu_f(bfhi(g.x))); w.y = pk2(bflo(o.y) * silu_f(bflo(g.y)), bfhi(o.y) * silu_f(bfhi(g.y)));
        w.z = pk2(bflo(o.z) * silu_f(bflo(g.z)), bfhi(o.z) * silu_f(bfhi(g.z))); w.w = pk2(bflo(o.w) * silu_f(bflo(g.w)), bfhi(o.w) * silu_f(bfhi(g.w)));
        *(uint4*)(Y + row * DM + 1024 + h * 64 + c16 * 8) = w; }
    __syncthreads();
}
}
namespace hg {
typedef float f32x16 __attribute__((ext_vector_type(16)));
typedef unsigned u32x4 __attribute__((ext_vector_type(4)));
typedef unsigned u32x2 __attribute__((ext_vector_type(2)));
constexpr int QS = 272, TS = 144;
constexpr int QD_OFF = 0, KD_OFF = 17408, KET_OFF = 34816, VT_OFF = 53248, ST_OFF = 71680, AM_OFF = 106496, DL_OFF = 115712, SS_OFF = 116224, GX_OFF = 117248, TOTAL_BYTES = 121344;
constexpr int SEGS = 8, SEG_TOK = 1024, CHUNKS = 16;
__device__ __forceinline__ unsigned cvtpk(float lo, float hi) { unsigned r; asm volatile("v_cvt_pk_bf16_f32 %0, %1, %2" : "=v"(r) : "v"(lo), "v"(hi)); return r; }
#define HG_ZERO16 {0.f,0.f,0.f,0.f,0.f,0.f,0.f,0.f,0.f,0.f,0.f,0.f,0.f,0.f,0.f,0.f}

struct Raw { unsigned q[8], f[8], v[8]; };
template <bool PASSB>
__device__ __forceinline__ void load_raw(Raw& R, const bf16* zc, int lane, int wave) {
    const bf16* zp = zc + (size_t)(8 * wave) * DIN + 2 * lane;
#pragma unroll
    for (int i = 0; i < 8; ++i) { R.f[i] = *(const unsigned*)(zp + (size_t)i * DIN + ZC_FH); R.v[i] = *(const unsigned*)(zp + (size_t)i * DIN + ZC_IH); if (PASSB) R.q[i] = *(const unsigned*)(zp + (size_t)i * DIN + ZC_QH); }
}
__device__ __forceinline__ float sig_fast(float x) { return __builtin_amdgcn_rcpf(1.f + __builtin_amdgcn_exp2f(-1.4426950408889634f * x)); }
template <bool PASSB>
__device__ __forceinline__ void elementwise(const Raw& R, LAS unsigned char* lds, int lane, int wave, float lb0, float lb1, float& dseg0, float& dseg1) {
    float f0[8], f1[8];
#pragma unroll
    for (int i = 0; i < 8; ++i) { f0[i] = lb0 + (1.f - lb0) * sig_fast(bflo(R.f[i])); f1[i] = lb1 + (1.f - lb1) * sig_fast(bfhi(R.f[i])); }
    float G0 = f0[0], G1 = f1[0];
#pragma unroll
    for (int i = 1; i < 8; ++i) { G0 *= f0[i]; G1 *= f1[i]; }
    typedef float f32x2v __attribute__((ext_vector_type(2)));
    *(LAS f32x2v*)(lds + GX_OFF + (wave * 128 + 2 * lane) * 4) = (f32x2v){G0, G1};
    __syncthreads();
    float pre0 = 1.f, pre1 = 1.f, post0 = 1.f, post1 = 1.f;
#pragma unroll
    for (int w2 = 0; w2 < 8; ++w2) { const f32x2v g = *(const LAS f32x2v*)(lds + GX_OFF + (w2 * 128 + 2 * lane) * 4);
        if (w2 < wave) { pre0 *= g.x; pre1 *= g.y; } else if (w2 > wave) { post0 *= g.x; post1 *= g.y; } }
    const float dl0 = pre0 * G0 * post0, dl1 = pre1 * G1 * post1;
    unsigned kew0[4], kew1[4];
    if (PASSB) {
        float D0 = pre0, D1 = pre1; float ke0[8], ke1[8];
#pragma unroll
        for (int i = 0; i < 8; ++i) { D0 *= f0[i]; D1 *= f1[i];
            const float r0 = __builtin_amdgcn_rcpf(D0), r1 = __builtin_amdgcn_rcpf(D1);
            const float q0 = bflo(R.q[i]), q1 = bfhi(R.q[i]);
            const float qd0 = q0 * sig_fast(q0) * D0, qd1 = q1 * sig_fast(q1) * D1;
            const float kd0 = (1.f - f0[i]) * r0, kd1 = (1.f - f1[i]) * r1; ke0[i] = kd0 * dl0; ke1[i] = kd1 * dl1;
            const int t = 8 * wave + i;
            *(LAS unsigned*)(lds + QD_OFF + t * QS + 4 * lane) = cvtpk(qd0, qd1);
            *(LAS unsigned*)(lds + KD_OFF + t * QS + 4 * lane) = cvtpk(kd0, kd1); }
#pragma unroll
        for (int i = 0; i < 4; ++i) { kew0[i] = cvtpk(ke0[2 * i], ke0[2 * i + 1]); kew1[i] = cvtpk(ke1[2 * i], ke1[2 * i + 1]); }
    } else {
        float Q0 = post0, Q1 = post1; float ke0[8], ke1[8];
#pragma unroll
        for (int i = 7; i >= 0; --i) { ke0[i] = (1.f - f0[i]) * Q0; ke1[i] = (1.f - f1[i]) * Q1; Q0 *= f0[i]; Q1 *= f1[i]; }
#pragma unroll
        for (int i = 0; i < 4; ++i) { kew0[i] = cvtpk(ke0[2 * i], ke0[2 * i + 1]); kew1[i] = cvtpk(ke1[2 * i], ke1[2 * i + 1]); }
        dseg0 *= dl0; dseg1 *= dl1;
    }
    *(LAS u32x4*)(lds + KET_OFF + (2 * lane) * TS + 16 * wave) = (u32x4){kew0[0], kew0[1], kew0[2], kew0[3]};
    *(LAS u32x4*)(lds + KET_OFF + (2 * lane + 1) * TS + 16 * wave) = (u32x4){kew1[0], kew1[1], kew1[2], kew1[3]};
    u32x4 v0, v1;
    v0.x = (R.v[0] & 0xffffu) | (R.v[1] << 16); v0.y = (R.v[2] & 0xffffu) | (R.v[3] << 16); v0.z = (R.v[4] & 0xffffu) | (R.v[5] << 16); v0.w = (R.v[6] & 0xffffu) | (R.v[7] << 16);
    v1.x = (R.v[0] >> 16) | (R.v[1] & 0xffff0000u); v1.y = (R.v[2] >> 16) | (R.v[3] & 0xffff0000u); v1.z = (R.v[4] >> 16) | (R.v[5] & 0xffff0000u); v1.w = (R.v[6] >> 16) | (R.v[7] & 0xffff0000u);
    *(LAS u32x4*)(lds + VT_OFF + (2 * lane) * TS + 16 * wave) = v0;
    *(LAS u32x4*)(lds + VT_OFF + (2 * lane + 1) * TS + 16 * wave) = v1;
    if (wave == 0) *(LAS f32x2v*)(lds + DL_OFF + 8 * lane) = (f32x2v){dl0, dl1};
}

__device__ __forceinline__ void state_update(f32x16& S0, f32x16& S1, LAS unsigned char* lds, int vb, int dbp, int ql, int hh) {
#pragma unroll
    for (int g = 0; g < 4; ++g) { const f32x4 d0 = *(const LAS f32x4*)(lds + DL_OFF + (32 * dbp + 8 * g + 4 * hh) * 4), d1 = *(const LAS f32x4*)(lds + DL_OFF + (32 * (dbp + 1) + 8 * g + 4 * hh) * 4);
#pragma unroll
        for (int e = 0; e < 4; ++e) { S0[4 * g + e] *= d0[e]; S1[4 * g + e] *= d1[e]; } }
#pragma unroll
    for (int ks = 0; ks < 4; ++ks) { const bf16x8 bv = *(const LAS bf16x8*)(lds + VT_OFF + (32 * vb + ql) * TS + (16 * ks + 8 * hh) * 2);
        const bf16x8 a0 = *(const LAS bf16x8*)(lds + KET_OFF + (32 * dbp + ql) * TS + (16 * ks + 8 * hh) * 2), a1 = *(const LAS bf16x8*)(lds + KET_OFF + (32 * (dbp + 1) + ql) * TS + (16 * ks + 8 * hh) * 2);
        S0 = __builtin_amdgcn_mfma_f32_32x32x16_bf16(a0, bv, S0, 0, 0, 0); S1 = __builtin_amdgcn_mfma_f32_32x32x16_bf16(a1, bv, S1, 0, 0, 0); }
}

__device__ __forceinline__ void passA_unit(const bf16* Z, float* Sloc, float* Dseg, const float* lb_logits, int unit, LAS unsigned char* lds, int tid, int lane, int wave) {
    const int s = unit & 7, bh = unit >> 3, h = bh & 7, b = bh >> 3;
    const int ql = lane & 31, hh = lane >> 5, vb = wave >> 1, dbp = (wave & 1) * 2;
    const int chn = h * 128 + 2 * lane;
    const float lb0 = 1.f / (1.f + __expf(lb_logits[1024 + chn] - lb_logits[chn])), lb1 = 1.f / (1.f + __expf(lb_logits[1024 + chn + 1] - lb_logits[chn + 1]));
    f32x16 S0 = HG_ZERO16, S1 = HG_ZERO16; float dseg0 = 1.f, dseg1 = 1.f;
    const bf16* zc0 = Z + ((size_t)b * SEQ + s * SEG_TOK) * DIN + h * 128;
    Raw R; load_raw<false>(R, zc0, lane, wave);
    for (int ch = 0; ch < CHUNKS; ++ch) {
        elementwise<false>(R, lds, lane, wave, lb0, lb1, dseg0, dseg1);
        if (ch + 1 < CHUNKS) load_raw<false>(R, zc0 + (size_t)(ch + 1) * 64 * DIN, lane, wave);
        __syncthreads();
        state_update(S0, S1, lds, vb, dbp, ql, hh);
        __syncthreads();
    }
    float* sl = Sloc + ((size_t)unit * 8 + wave) * 2048;
#pragma unroll
    for (int r = 0; r < 16; ++r) { sl[r * 64 + lane] = S0[r]; sl[(16 + r) * 64 + lane] = S1[r]; }
    if (wave == 0) { Dseg[(size_t)unit * 128 + 2 * lane] = dseg0; Dseg[(size_t)unit * 128 + 2 * lane + 1] = dseg1; }
}

__device__ __forceinline__ void store_state_bf16(const f32x16& S0, const f32x16& S1, LAS unsigned char* lds, int vb, int dbp, int ql, int hh) {
#pragma unroll
    for (int g = 0; g < 4; ++g) {
        u32x2 w0; w0.x = cvtpk(S0[4*g+0], S0[4*g+1]); w0.y = cvtpk(S0[4*g+2], S0[4*g+3]);
        u32x2 w1; w1.x = cvtpk(S1[4*g+0], S1[4*g+1]); w1.y = cvtpk(S1[4*g+2], S1[4*g+3]);
        *(LAS u32x2*)(lds + ST_OFF + (32 * vb + ql) * QS + (32 * dbp + 8 * g + 4 * hh) * 2) = w0;
        *(LAS u32x2*)(lds + ST_OFF + (32 * vb + ql) * QS + (32 * (dbp + 1) + 8 * g + 4 * hh) * 2) = w1; }
}

__device__ __forceinline__ void passB_unit(const bf16* Z, bf16* Y, const float* Sloc, const float* Dseg, const float* lb_logits, const float* gnorm, int unit, LAS unsigned char* lds, int tid, int lane, int wave) {
    const int s = unit & 7, bh = unit >> 3, h = bh & 7, b = bh >> 3;
    const int ql = lane & 31, hh = lane >> 5, vb = wave >> 1, dbp = (wave & 1) * 2, cb = wave & 1;
    const int chn = h * 128 + 2 * lane;
    const float lb0 = 1.f / (1.f + __expf(lb_logits[1024 + chn] - lb_logits[chn])), lb1 = 1.f / (1.f + __expf(lb_logits[1024 + chn + 1] - lb_logits[chn + 1]));
    f32x16 S0 = HG_ZERO16, S1 = HG_ZERO16; float dummy0 = 1.f, dummy1 = 1.f;
    const bf16* zc0 = Z + ((size_t)b * SEQ + s * SEG_TOK) * DIN + h * 128;
    Raw R; load_raw<true>(R, zc0, lane, wave);
    float4 gn[4];
#pragma unroll
    for (int g = 0; g < 4; ++g) gn[g] = *(const float4*)(gnorm + 32 * vb + 8 * g + 4 * hh);
    for (int sp = 0; sp < s; ++sp) {
        const float* sl = Sloc + ((size_t)(bh * 8 + sp) * 8 + wave) * 2048; const float* dg = Dseg + (size_t)(bh * 8 + sp) * 128;
#pragma unroll
        for (int r = 0; r < 16; ++r) { const int dd = (r & 3) + 8 * (r >> 2) + 4 * hh;
            S0[r] = S0[r] * dg[32 * dbp + dd] + sl[r * 64 + lane]; S1[r] = S1[r] * dg[32 * (dbp + 1) + dd] + sl[(16 + r) * 64 + lane]; }
    }
    store_state_bf16(S0, S1, lds, vb, dbp, ql, hh);
    for (int ch = 0; ch < CHUNKS; ++ch) {
        const size_t row0 = (size_t)b * SEQ + s * SEG_TOK + ch * 64;
        elementwise<true>(R, lds, lane, wave, lb0, lb1, dummy0, dummy1);
        if (ch + 1 < CHUNKS) load_raw<true>(R, zc0 + (size_t)(ch + 1) * 64 * DIN, lane, wave);
        const int cc = 32 * cb + ql;
        const bf16* grow = Z + (row0 + cc) * DIN + ZC_GH + h * 128; bf16* yrow = Y + (row0 + cc) * DM + h * 128;
        uint2 gwv[4];
#pragma unroll
        for (int g = 0; g < 4; ++g) gwv[g] = *(const uint2*)(grow + 32 * vb + 8 * g + 4 * hh);
        __syncthreads();
        f32x16 O = HG_ZERO16;
#pragma unroll
        for (int ks = 0; ks < 8; ++ks) { const bf16x8 a = *(const LAS bf16x8*)(lds + ST_OFF + (32 * vb + ql) * QS + (16 * ks + 8 * hh) * 2), bq = *(const LAS bf16x8*)(lds + QD_OFF + (32 * cb + ql) * QS + (16 * ks + 8 * hh) * 2);
            O = __builtin_amdgcn_mfma_f32_32x32x16_bf16(a, bq, O, 0, 0, 0); }
        state_update(S0, S1, lds, vb, dbp, ql, hh);
        if (wave < 3) {
            const int sb = (wave == 2) ? 1 : 0, cb2 = (wave == 0) ? 0 : 1;
            f32x16 A = HG_ZERO16;
#pragma unroll
            for (int ks = 0; ks < 8; ++ks) { const bf16x8 a = *(const LAS bf16x8*)(lds + KD_OFF + (32 * sb + ql) * QS + (16 * ks + 8 * hh) * 2), bq = *(const LAS bf16x8*)(lds + QD_OFF + (32 * cb2 + ql) * QS + (16 * ks + 8 * hh) * 2);
                A = __builtin_amdgcn_mfma_f32_32x32x16_bf16(a, bq, A, 0, 0, 0); }
            if (sb == cb2) {
#pragma unroll
                for (int r = 0; r < 16; ++r) if ((r & 3) + 8 * (r >> 2) + 4 * hh > ql) A[r] = 0.f;
            }
#pragma unroll
            for (int g = 0; g < 4; ++g) { u32x2 w; w.x = cvtpk(A[4*g+0], A[4*g+1]); w.y = cvtpk(A[4*g+2], A[4*g+3]);
                *(LAS u32x2*)(lds + AM_OFF + (32 * cb2 + ql) * TS + (32 * sb + 8 * g + 4 * hh) * 2) = w; }
        }
        __syncthreads();
        store_state_bf16(S0, S1, lds, vb, dbp, ql, hh);
        if (cb) {
#pragma unroll
            for (int ks = 0; ks < 4; ++ks) { const bf16x8 a = *(const LAS bf16x8*)(lds + VT_OFF + (32 * vb + ql) * TS + (16 * ks + 8 * hh) * 2), bq = *(const LAS bf16x8*)(lds + AM_OFF + (32 + ql) * TS + (16 * ks + 8 * hh) * 2);
                O = __builtin_amdgcn_mfma_f32_32x32x16_bf16(a, bq, O, 0, 0, 0); }
        } else {
#pragma unroll
            for (int ks = 0; ks < 2; ++ks) { const bf16x8 a = *(const LAS bf16x8*)(lds + VT_OFF + (32 * vb + ql) * TS + (16 * ks + 8 * hh) * 2), bq = *(const LAS bf16x8*)(lds + AM_OFF + ql * TS + (16 * ks + 8 * hh) * 2);
                O = __builtin_amdgcn_mfma_f32_32x32x16_bf16(a, bq, O, 0, 0, 0); }
        }
        float ssq = 0.f;
#pragma unroll
        for (int r = 0; r < 16; ++r) ssq += O[r] * O[r];
        ssq += __shfl_xor(ssq, 32);
        if (hh == 0) *(LAS float*)(lds + SS_OFF + (vb * 64 + 32 * cb + ql) * 4) = ssq;
        __syncthreads();
        const float tot = (*(const LAS float*)(lds + SS_OFF + cc * 4) + *(const LAS float*)(lds + SS_OFF + (64 + cc) * 4)) + (*(const LAS float*)(lds + SS_OFF + (128 + cc) * 4) + *(const LAS float*)(lds + SS_OFF + (192 + cc) * 4));
        const float rstd = 1.f / sqrtf(tot * (1.f / 128.f) + NORM_EPS);
#pragma unroll
        for (int g = 0; g < 4; ++g) { const int v0 = 32 * vb + 8 * g + 4 * hh; const uint2 gw = gwv[g];
            const float x0 = bflo(gw.x), x1 = bfhi(gw.x), x2 = bflo(gw.y), x3 = bfhi(gw.y);
            uint2 w; w.x = cvtpk(O[4*g+0] * rstd * gn[g].x * x0 * sig_fast(x0), O[4*g+1] * rstd * gn[g].y * x1 * sig_fast(x1));
            w.y = cvtpk(O[4*g+2] * rstd * gn[g].z * x2 * sig_fast(x2), O[4*g+3] * rstd * gn[g].w * x3 * sig_fast(x3));
            *(uint2*)(yrow + v0) = w; }
    }
    __syncthreads();
}
}
struct Args { const float* x; const float* norm_gain; const float* w_in; const float* lb_logits; const float* hgrn_gnorm; const float* w_out; const float* final_gain; float* out; unsigned char* ws; };
__global__ void __launch_bounds__(NWAVES * 64, 2) fwd_kernel(Args a) {
    __shared__ __attribute__((aligned(16))) unsigned char lds_raw[LDS_BYTES];
    LAS unsigned char* lds = (LAS unsigned char*)lds_raw;
    volatile LAS unsigned* MISC = (volatile LAS unsigned*)(lds + MISC_OFF);
    const int tid = threadIdx.x, lane = tid & 63, wave = __builtin_amdgcn_readfirstlane(tid >> 6);
    const int G = gridDim.x; const int bx = blockIdx.x; const int vcu = (G % 8 == 0) ? (bx % 8) * (G / 8) + bx / 8 : bx;
    unsigned char* ws = a.ws;
    gu32* ctl = (gu32*)(ws + WS_CTL);
    bf16* WIN_T = (bf16*)(ws + WS_WIN); bf16* WOUT_T = (bf16*)(ws + WS_WOUT); bf16* XN = (bf16*)(ws + WS_XN); bf16* Y = (bf16*)(ws + WS_Y); bf16* Z = (bf16*)(ws + WS_Z); float* SLOC = (float*)(ws + WS_SLOC); float* DSEG = (float*)(ws + WS_DSEG);
    for (int u = tid; u < (LDS_BYTES - LDSCTL_OFF) / 4; u += NWAVES * 64) ((LAS unsigned*)(lds + LDSCTL_OFF))[u] = 0u;
    __syncthreads();
    XcdBarrier bar = xcd_barrier_post((unsigned*)(ctl + CW_BAR), MISC + 8);
    const int gw = vcu * NWAVES + wave, NGW = G * NWAVES;

    {
        LAS float* scr = (LAS float*)(lds + RING_OFF + wave * 16384);
        constexpr int I_IN = (DM / 64) * (DIN / 32), I_OUT = (DM / 64) * (DM / 32);
        for (int it = gw; it < I_IN + I_OUT; it += NGW) {
            if (it < I_IN) p0_transpose_item(a.w_in, DM, DIN, WIN_T, scr, it, lane);
            else p0_transpose_item(a.w_out, DM, DM, WOUT_T, scr, it - I_IN, lane);
        }
        for (int m = gw; m < M; m += NGW) rms_row_to_bf16(a.x + (size_t)m * DM, a.norm_gain, XN + (size_t)m * DM, lane);
    }
    xcd_barrier(bar);
    {
        pg8::Gemm g{XN, WIN_T, M, DIN, DM}; pg8::StaticOrder S; S.init(M, DIN, G, bx);
        pg8::EpiBf16 E{Z, DIN};
        pg8::gemm_phase<pg8::EpiBf16, pg8::StaticOrder, true, true>(lds + RING_OFF, g, S, E);
    }
    xcd_barrier(bar);
    {
        if ((vcu & 7) != 7 && vcu < 256) hg::passA_unit(Z, SLOC, DSEG, a.lb_logits, vcu, lds + RING_OFF, tid, lane, wave);
        for (int it = vcu; it < BATCH * AT_HEADS * 16; it += G) att::unit(Z, Y, it, lds + RING_OFF, tid, lane, wave);
    }
    xcd_barrier(bar);
    for (int u = vcu; u < 256; u += G) hg::passB_unit(Z, Y, SLOC, DSEG, a.lb_logits, a.hgrn_gnorm, u, lds + RING_OFF, tid, lane, wave);
    xcd_barrier(bar);
    {
        pg8::Gemm g{Y, WOUT_T, M, DM, DM}; pg8::StaticOrder S; S.init(M, DM, G, bx);
        pg8::EpiResF32 E{a.x, a.out, DM};
        pg8::gemm_phase<pg8::EpiResF32, pg8::StaticOrder, true, true>(lds + RING_OFF, g, S, E);
    }
    xcd_barrier(bar);
    for (int m = gw; m < M; m += NGW) rms_row_inplace(a.out + (size_t)m * DM, a.final_gain, lane);
}

extern "C" void kernel_launch(void* const* d_in, const int* in_sizes, int n_in, void* d_out, int out_size, void* d_ws, size_t ws_size, hipStream_t stream) {
    static int grid = 0;
    if (grid == 0) {
        if (n_in != 7 || in_sizes[0] != M * DM || out_size != M * DM || ws_size < WS_END) { fprintf(stderr, "kernel_launch: unexpected shapes (n_in %d in0 %d out %d ws %zu)\n", n_in, n_in > 0 ? in_sizes[0] : -1, out_size, ws_size); grid = -1; return; }
        int dev = 0, cus = 0;
        if (hipGetDevice(&dev) != hipSuccess || hipDeviceGetAttribute(&cus, hipDeviceAttributeMultiprocessorCount, dev) != hipSuccess) { grid = -1; return; }
        grid = cus;
    }
    if (grid < 0) return;
    (void)hipMemsetAsync((char*)d_ws + WS_CTL, 0, CTL_ZERO_BYTES, stream);
    Args a{};
    a.x = (const float*)d_in[0]; a.norm_gain = (const float*)d_in[1]; a.w_in = (const float*)d_in[2]; a.lb_logits = (const float*)d_in[3];
    a.hgrn_gnorm = (const float*)d_in[4]; a.w_out = (const float*)d_in[5]; a.final_gain = (const float*)d_in[6];
    a.out = (float*)d_out; a.ws = (unsigned char*)d_ws;
    hipLaunchKernelGGL(fwd_kernel, dim3(grid), dim3(NWAVES * 64), 0, stream, a);
}
```
